# Optimizing an MI355X kernel written in HIP

```python
import math
import jax
import jax.numpy as jnp
from jax import lax
import numpy as np

D_MODEL = 1024
BATCH = 2
SEQ = 16384
DEPTH = 2

GRID_W = 64
CTX_LEN = 256
F32 = jnp.float32
EPS = 1e-6

N_MIXERS = 4
D_GROUP = D_MODEL // N_MIXERS

POOL_WINDOWS = (2, 4, 8, 16)
POOL_CH = D_GROUP // len(POOL_WINDOWS)

HEAD_DIM = 64
N_Q_HEADS = D_GROUP // HEAD_DIM
N_KV_HEADS = N_Q_HEADS // 2
Q_GROUP = N_Q_HEADS // N_KV_HEADS
ROPE_AXIS_DIM = HEAD_DIM // 2
ROPE_FREQS = ROPE_AXIS_DIM // 2
ROPE_THETA = 10000.0
Q_BLOCK = 128
ATTN_SCALE = HEAD_DIM ** -0.5

LRU_WIDTH = D_GROUP
LRU_BLOCKS = 4
LRU_BLOCK_W = LRU_WIDTH // LRU_BLOCKS
LRU_CONV = 4
LRU_C = 8.0

HY_WIDTH = D_GROUP
HY_ORDER = 2
HY_SHORT = 3
HY_EMB = 33
HY_BANDS = (HY_EMB - 1) // 2
HY_HIDDEN = 64
HY_TARGET = 1e-2
HY_FAST = 0.3
HY_SLOW = 1.5
HY_MIN_DECAY = math.log(HY_TARGET) / HY_SLOW
HY_MAX_DECAY = math.log(HY_TARGET) / HY_FAST

D_FF = 4 * D_MODEL

Q_COLS = N_Q_HEADS * HEAD_DIM
KV_COLS = N_KV_HEADS * HEAD_DIM
HY_COLS = (HY_ORDER + 1) * HY_WIDTH
COL_SPLITS = (D_GROUP,
              D_GROUP + Q_COLS,
              D_GROUP + Q_COLS + KV_COLS,
              D_GROUP + Q_COLS + 2 * KV_COLS,
              D_GROUP + Q_COLS + 2 * KV_COLS + LRU_WIDTH,
              D_GROUP + Q_COLS + 2 * KV_COLS + 2 * LRU_WIDTH)
IN_COLS = COL_SPLITS[-1] + HY_COLS

kernel_name = 'hybrid_pool_gqa_rglru_hyena_dit'


def rmsnorm(x, g):
    xf = x.astype(F32)
    y = xf * lax.rsqrt(jnp.mean(xf * xf, axis=-1, keepdims=True) + EPS)
    return (y * g.astype(F32)).astype(x.dtype)


def modulate(h, shift, scale):
    return h * (1.0 + scale) + shift


def depthwise_conv(u, w, b, left):
    width = w.shape[0]
    L = u.shape[1]
    up = jnp.pad(u, ((0, 0), (left, width - 1 - left), (0, 0)))
    out = b
    for j in range(width):
        out = out + up[:, j:j + L] * w[j]
    return out


def pool_mixer(u, w, scale):
    L = u.shape[1]
    uf = u.astype(F32)
    cs = jnp.pad(jnp.cumsum(uf, axis=1), ((0, 0), (1, 0), (0, 0)))
    t = jnp.arange(L)
    outs = []
    for gi, win in enumerate(POOL_WINDOWS):
        sl = slice(gi * POOL_CH, (gi + 1) * POOL_CH)
        lo = jnp.clip(t - win // 2, 0, L)
        hi = jnp.clip(t + win - win // 2, 0, L)
        csg = cs[..., sl]
        mean = (csg[:, hi] - csg[:, lo]) / (hi - lo).astype(F32)[None, :, None]
        d = (mean - uf[..., sl]).astype(u.dtype)
        outs.append(d @ w[gi])
    return jnp.concatenate(outs, axis=-1) * scale


def axial_rope_tables(rows):
    row = jnp.repeat(jnp.arange(rows), GRID_W).astype(F32)
    col = jnp.tile(jnp.arange(GRID_W), rows).astype(F32)
    inv = ROPE_THETA ** (-jnp.arange(ROPE_FREQS, dtype=F32) / ROPE_FREQS)
    ang = jnp.stack([row[:, None] * inv, col[:, None] * inv], axis=1)
    return jnp.cos(ang), jnp.sin(ang)


def apply_axial_rope(t, cos, sin):
    B, L, H, _ = t.shape
    ts = t.reshape(B, L, H, 2, 2, ROPE_FREQS)
    t1, t2 = ts[..., 0, :], ts[..., 1, :]
    c = cos[None, :, None]
    s = sin[None, :, None]
    out = jnp.stack([t1 * c - t2 * s, t2 * c + t1 * s], axis=-2)
    return out.reshape(B, L, H, HEAD_DIM).astype(t.dtype)


def attend(q, k, v):
    s = jnp.einsum('bkgqd,bksd->bkgqs', q, k).astype(F32) * ATTN_SCALE
    p = jax.nn.softmax(s, axis=-1)
    return jnp.einsum('bkgqs,bksd->bkgqd', p.astype(v.dtype), v)


def attention_mixer(qx, kx, vx, qc, kc, vc, gq, gk, cos_t, sin_t, need_ctx):
    B, L = qx.shape[0], qx.shape[1]
    C = qc.shape[1]
    qx = apply_axial_rope(rmsnorm(qx.reshape(B, L, N_Q_HEADS, HEAD_DIM), gq), cos_t, sin_t)
    kx = apply_axial_rope(rmsnorm(kx.reshape(B, L, N_KV_HEADS, HEAD_DIM), gk), cos_t, sin_t)
    vx = vx.reshape(B, L, N_KV_HEADS, HEAD_DIM)
    kc = rmsnorm(kc.reshape(B, C, N_KV_HEADS, HEAD_DIM), gk)
    vc = vc.reshape(B, C, N_KV_HEADS, HEAD_DIM)
    k_all = jnp.concatenate([kc, kx], axis=1).transpose(0, 2, 1, 3)
    v_all = jnp.concatenate([vc, vx], axis=1).transpose(0, 2, 1, 3)
    nblk = L // Q_BLOCK
    qb = qx.reshape(B, nblk, Q_BLOCK, N_KV_HEADS, Q_GROUP, HEAD_DIM).transpose(1, 0, 3, 4, 2, 5)
    ob = lax.map(lambda q: attend(q, k_all, v_all), qb)
    ox = ob.transpose(1, 0, 4, 2, 3, 5).reshape(B, L, D_GROUP)
    if not need_ctx:
        return ox, None
    qc = rmsnorm(qc.reshape(B, C, N_Q_HEADS, HEAD_DIM), gq)
    qcb = qc.reshape(B, C, N_KV_HEADS, Q_GROUP, HEAD_DIM).transpose(0, 2, 3, 1, 4)
    oc = attend(qcb, kc.transpose(0, 2, 1, 3), vc.transpose(0, 2, 1, 3))
    oc = oc.transpose(0, 3, 1, 2, 4).reshape(B, C, D_GROUP)
    return ox, oc


def rglru_coeffs(xc, wa, b_r, wx, b_i, lam):
    xf = xc.astype(F32)
    xb = xf.reshape(xf.shape[0], xf.shape[1], LRU_BLOCKS, LRU_BLOCK_W)
    r = jax.nn.sigmoid(jnp.einsum('blnc,ncd->blnd', xb, wa.astype(F32)).reshape(xf.shape) + b_r)
    i = jax.nn.sigmoid(jnp.einsum('blnc,ncd->blnd', xb, wx.astype(F32)).reshape(xf.shape) + b_i)
    log_a = -LRU_C * r * jax.nn.softplus(-lam.astype(F32))
    a = jnp.exp(log_a)
    b = jnp.sqrt(-jnp.expm1(2.0 * log_a)) * (i * xf)
    return a, b


def linear_scan(a, b, h0):
    b = b.at[:, 0].add(a[:, 0] * h0)

    def combine(l, r):
        return (l[0] * r[0], r[0] * l[1] + r[1])

    _, h = lax.associative_scan(combine, (a, b), axis=1)
    return h


def rglru_mixer(ux, gx, uc, gc, conv_w, conv_b, wa, b_r, wx, b_i, lam, need_ctx):
    xcx = depthwise_conv(ux, conv_w, conv_b, LRU_CONV // 2)
    xcc = depthwise_conv(uc, conv_w, conv_b, LRU_CONV // 2)
    B = ux.shape[0]
    hx_sum = jnp.zeros(ux.shape, F32)
    hc_sum = jnp.zeros(uc.shape, F32)
    for d in range(2):
        ax, bx = rglru_coeffs(xcx, wa[d], b_r[d], wx[d], b_i[d], lam[d])
        ac, bc = rglru_coeffs(xcc, wa[d], b_r[d], wx[d], b_i[d], lam[d])
        if d == 1:
            ax, bx, ac, bc = ax[:, ::-1], bx[:, ::-1], ac[:, ::-1], bc[:, ::-1]
        hc = linear_scan(ac, bc, jnp.zeros((B, LRU_WIDTH), F32))
        hx = linear_scan(ax, bx, hc[:, -1])
        if d == 1:
            hc, hx = hc[:, ::-1], hx[:, ::-1]
        hx_sum = hx_sum + hx
        hc_sum = hc_sum + hc
    yx = (hx_sum * jax.nn.gelu(gx.astype(F32))).astype(ux.dtype)
    if not need_ctx:
        return yx, None
    yc = (hc_sum * jax.nn.gelu(gc.astype(F32))).astype(uc.dtype)
    return yx, yc


def hyena_filter_spectrum(L, w1, b1, freq, w2, b2, w3):
    t01 = jnp.linspace(0.0, 1.0, L, dtype=F32)[:, None]
    w = 2.0 * math.pi * jnp.arange(L, dtype=F32) / L
    bands = jnp.linspace(1e-4, HY_BANDS - 1, HY_BANDS, dtype=F32)
    z = w[:, None] * bands[None, :]
    emb = jnp.concatenate([t01, jnp.cos(z), -jnp.sin(z)], axis=-1)
    fq = freq.astype(F32)
    h = jnp.sin(fq * (emb @ w1.astype(F32) + b1.astype(F32)))
    h = jnp.sin(fq * (h @ w2.astype(F32) + b2.astype(F32)))
    h = (h @ w3.astype(F32)).reshape(L, 2, HY_ORDER, HY_WIDTH)
    deltas = jnp.abs(jnp.linspace(HY_MIN_DECAY, HY_MAX_DECAY, HY_WIDTH, dtype=F32))
    h = h * jnp.exp(-t01 * deltas)[:, None, None, :]
    filt = jnp.concatenate([h[:, 0], jnp.zeros((1, HY_ORDER, HY_WIDTH), F32), h[:0:-1, 1]], axis=0)
    filt = filt / jnp.sum(jnp.abs(filt), axis=0, keepdims=True)
    return jnp.fft.rfft(filt, axis=0)


def fft_long_conv(u, spec, skip):
    L = u.shape[1]
    uf = u.astype(F32)
    U = jnp.fft.rfft(uf, n=2 * L, axis=1)
    y = jnp.fft.irfft(U * spec[None], n=2 * L, axis=1)[:, :L]
    return (y + uf * skip.astype(F32)).astype(u.dtype)


def hyena_mixer(u, conv_w, conv_b, w1, b1, freq, w2, b2, w3, skip):
    L = u.shape[1]
    z = depthwise_conv(u, conv_w, conv_b, HY_SHORT // 2)
    x1, x2, v = jnp.split(z, 3, axis=-1)
    spec = hyena_filter_spectrum(L, w1, b1, freq, w2, b2, w3)
    y = x1 * fft_long_conv(v, spec[:, 0], skip[0])
    y = x2 * fft_long_conv(y, spec[:, 1], skip[1])
    return y


def sq_relu_mlp(h, w1, w2):
    return jnp.square(jax.nn.relu(h @ w1)) @ w2


def setup_inputs(seed: int = 0) -> dict:
    key = jax.random.key(seed)
    keys = list(jax.random.split(key, 40))

    def nrm(shape, scale):
        return jax.random.normal(keys.pop(), shape, F32) * scale

    a8 = jax.random.uniform(keys.pop(), (DEPTH, 2, LRU_WIDTH), F32, minval=0.9, maxval=0.999)
    a = a8 ** (1.0 / LRU_C)
    lru_lambda = jnp.log(a) - jnp.log1p(-a)
    return {
        'x': nrm((BATCH, SEQ, D_MODEL), 1.0),
        'c': nrm((BATCH, D_MODEL), 1.0),
        'ctx': nrm((BATCH, CTX_LEN, D_MODEL), 1.0),
        'c_ctx': nrm((D_MODEL,), 1.0),
        'w_mod': nrm((DEPTH, D_MODEL, 6 * D_MODEL), 0.5 * D_MODEL ** -0.5),
        'b_mod': nrm((DEPTH, 6 * D_MODEL), 0.02),
        'g_pre_mix': 1.0 + nrm((DEPTH, D_MODEL), 0.05),
        'g_post_mix': 1.0 + nrm((DEPTH, D_MODEL), 0.05),
        'g_pre_mlp': 1.0 + nrm((DEPTH, D_MODEL), 0.05),
        'g_post_mlp': 1.0 + nrm((DEPTH, D_MODEL), 0.05),
        'w_in': nrm((DEPTH, D_MODEL, IN_COLS), D_MODEL ** -0.5),
        'w_out': nrm((DEPTH, D_MODEL, D_MODEL), D_MODEL ** -0.5),
        'pool_w': nrm((DEPTH, len(POOL_WINDOWS), POOL_CH, POOL_CH), POOL_CH ** -0.5),
        'pool_scale': 1.0 + nrm((DEPTH, D_GROUP), 0.1),
        'q_norm_g': 1.0 + nrm((DEPTH, HEAD_DIM), 0.05),
        'k_norm_g': 1.0 + nrm((DEPTH, HEAD_DIM), 0.05),
        'lru_conv_w': nrm((DEPTH, LRU_CONV, LRU_WIDTH), LRU_CONV ** -0.5),
        'lru_conv_b': nrm((DEPTH, LRU_WIDTH), 0.02),
        'lru_wa': nrm((DEPTH, 2, LRU_BLOCKS, LRU_BLOCK_W, LRU_BLOCK_W), LRU_BLOCK_W ** -0.5),
        'lru_ba': nrm((DEPTH, 2, LRU_WIDTH), 0.1),
        'lru_wx': nrm((DEPTH, 2, LRU_BLOCKS, LRU_BLOCK_W, LRU_BLOCK_W), LRU_BLOCK_W ** -0.5),
        'lru_bx': nrm((DEPTH, 2, LRU_WIDTH), 0.1),
        'lru_lambda': lru_lambda,
        'hy_conv_w': nrm((DEPTH, HY_SHORT, HY_COLS), HY_SHORT ** -0.5),
        'hy_conv_b': nrm((DEPTH, HY_COLS), 0.02),
        'hy_w1': nrm((DEPTH, HY_EMB, HY_HIDDEN), HY_EMB ** -0.5),
        'hy_b1': nrm((DEPTH, HY_HIDDEN), 0.1),
        'hy_freq': 1.0 + nrm((DEPTH, HY_HIDDEN), 0.05),
        'hy_w2': nrm((DEPTH, HY_HIDDEN, HY_HIDDEN), HY_HIDDEN ** -0.5),
        'hy_b2': nrm((DEPTH, HY_HIDDEN), 0.1),
        'hy_w3': nrm((DEPTH, HY_HIDDEN, 2 * HY_ORDER * HY_WIDTH), HY_HIDDEN ** -0.5),
        'hy_skip': nrm((DEPTH, HY_ORDER, HY_WIDTH), 0.5),
        'mlp_w1': nrm((DEPTH, D_MODEL, D_FF), D_MODEL ** -0.5),
        'mlp_w2': nrm((DEPTH, D_FF, D_MODEL), D_FF ** -0.5),
    }


def reference(x, c, ctx, c_ctx, w_mod, b_mod, g_pre_mix, g_post_mix, g_pre_mlp, g_post_mlp,
              w_in, w_out, pool_w, pool_scale, q_norm_g, k_norm_g,
              lru_conv_w, lru_conv_b, lru_wa, lru_ba, lru_wx, lru_bx, lru_lambda,
              hy_conv_w, hy_conv_b, hy_w1, hy_b1, hy_freq, hy_w2, hy_b2, hy_w3, hy_skip,
              mlp_w1, mlp_w2):
    L = x.shape[1]
    rows = L // GRID_W
    cos_t, sin_t = axial_rope_tables(rows)
    cx = ctx
    cond_x = jax.nn.silu(c)
    cond_c = jax.nn.silu(c_ctx)
    for l in range(DEPTH):
        need_ctx = l < DEPTH - 1
        mod_x = (cond_x @ w_mod[l] + b_mod[l])[:, None, :]
        mod_c = (cond_c @ w_mod[l] + b_mod[l])[None, None, :]
        sh1x, sc1x, ga1x, sh2x, sc2x, ga2x = jnp.split(mod_x, 6, axis=-1)
        sh1c, sc1c, ga1c, sh2c, sc2c, ga2c = jnp.split(mod_c, 6, axis=-1)

        px = jnp.split(modulate(rmsnorm(x, g_pre_mix[l]), sh1x, sc1x) @ w_in[l], COL_SPLITS, axis=-1)
        pc = jnp.split(modulate(rmsnorm(cx, g_pre_mix[l]), sh1c, sc1c) @ w_in[l], COL_SPLITS, axis=-1)

        ya_x = pool_mixer(px[0], pool_w[l], pool_scale[l])
        yb_x, yb_c = attention_mixer(px[1], px[2], px[3], pc[1], pc[2], pc[3],
                                     q_norm_g[l], k_norm_g[l], cos_t, sin_t, need_ctx)
        yc_x, yc_c = rglru_mixer(px[4], px[5], pc[4], pc[5], lru_conv_w[l], lru_conv_b[l],
                                 lru_wa[l], lru_ba[l], lru_wx[l], lru_bx[l], lru_lambda[l], need_ctx)
        yd_x = hyena_mixer(px[6], hy_conv_w[l], hy_conv_b[l], hy_w1[l], hy_b1[l], hy_freq[l],
                           hy_w2[l], hy_b2[l], hy_w3[l], hy_skip[l])

        mix_x = jnp.concatenate([ya_x, yb_x, yc_x, yd_x], axis=-1) @ w_out[l]
        x = x + ga1x * rmsnorm(mix_x, g_post_mix[l])
        h_x = modulate(rmsnorm(x, g_pre_mlp[l]), sh2x, sc2x)
        x = x + ga2x * rmsnorm(sq_relu_mlp(h_x, mlp_w1[l], mlp_w2[l]), g_post_mlp[l])

        if need_ctx:
            ya_c = pool_mixer(pc[0], pool_w[l], pool_scale[l])
            yd_c = hyena_mixer(pc[6], hy_conv_w[l], hy_conv_b[l], hy_w1[l], hy_b1[l], hy_freq[l],
                               hy_w2[l], hy_b2[l], hy_w3[l], hy_skip[l])
            mix_c = jnp.concatenate([ya_c, yb_c, yc_c, yd_c], axis=-1) @ w_out[l]
            cx = cx + ga1c * rmsnorm(mix_c, g_post_mix[l])
            h_c = modulate(rmsnorm(cx, g_pre_mlp[l]), sh2c, sc2c)
            cx = cx + ga2c * rmsnorm(sq_relu_mlp(h_c, mlp_w1[l], mlp_w2[l]), g_post_mlp[l])
    return x
```

```cpp
#include <hip/hip_runtime.h>
#include <hip/hip_cooperative_groups.h>
#include <cstdio>
#include <cstdint>
namespace cg = cooperative_groups;
#ifndef PROBE_ATT
#define PROBE_ATT 0
#endif
#ifndef PROBE_GEMM
#define PROBE_GEMM 0
#endif
#ifndef PROBE_PREP
#define PROBE_PREP 0
#endif
#ifndef PROBE_HY
#define PROBE_HY 0
#endif
#ifndef PROBE_SYNC
#define PROBE_SYNC 0
#endif
#ifndef PROBE_P0
#define PROBE_P0 0
#endif
#ifndef PROBE_FT
#define PROBE_FT 0
#endif
#ifndef PROBE_TR
#define PROBE_TR 0
#endif
#ifndef PROBE_ROWS
#define PROBE_ROWS 0
#endif
namespace pg8 {
#define PG8_LAS __attribute__((address_space(3)))
typedef unsigned short bf16_t;
typedef short bf16x8 __attribute__((ext_vector_type(8)));
typedef float f32x4 __attribute__((ext_vector_type(4)));
typedef unsigned u32x4 __attribute__((ext_vector_type(4)));
constexpr int BM = 256, BK = 64, HALF = 128, HTB = HALF * BK * 2  , STAGE_BYTES = 8 * HTB, NXCD = 8, WGM = 8;

__host__ __device__ __forceinline__ int lds_byte(int r, int c) { const int st = (r >> 4) * 2 + (c >> 5), rr = r & 15, cc = c & 31, ob = rr * 64 + cc * 2; return st * 1024 + (ob ^ (((ob >> 9) & 1) << 5)); }
__host__ __device__ __forceinline__ void stage_rc(int b, int& R, int& C) { const int st = b / 1024, sb = b % 1024, swz = sb ^ (((sb >> 9) & 1) << 5); R = (st >> 1) * 16 + swz / 64; C = (st & 1) * 32 + (swz % 64) / 2; }
__host__ __device__ __forceinline__ int perm32(int rho) { const int n = rho >> 4, i = rho & 15; return 8 * (i >> 2) + 4 * n + (i & 3); }

struct Unit { int pm, pn; };
struct Gemm { const bf16_t* A; const bf16_t* Bt; int M, N, K; };

struct StaticOrder {
    int nM, nN, nwg, G, c;
    __host__ __device__ void init(int M, int N, int G_, int c_) { nM = M / BM; nN = N / BM; nwg = nM * nN; G = G_; c = c_; }
    __host__ __device__ bool next(int i, Unit& u) const {
        const long L = (long)i * G + c; if (L >= nwg) return false;
        int wgid = (int)L; { const int q = nwg / NXCD, r = nwg % NXCD, xcd = wgid % NXCD, off = wgid / NXCD; wgid = (xcd < r ? xcd * (q + 1) : r * (q + 1) + (xcd - r) * q) + off; }
        const int nig = WGM * nN, gid = wgid / nig, fm = gid * WGM, gsz = (nM - fm) < WGM ? (nM - fm) : WGM;
        u.pm = fm + ((wgid % nig) % gsz); u.pn = (wgid % nig) / gsz; return true;
    }
    __device__ __forceinline__ void a_ready(const Unit&) const {}
    __device__ __forceinline__ void done(const Unit&) const {}
};
__device__ __forceinline__ unsigned cvt_pk_bf16(float lo, float hi) { unsigned r; asm volatile("v_cvt_pk_bf16_f32 %0, %1, %2" : "=v"(r) : "v"(lo), "v"(hi)); return r; }
typedef float f32x2 __attribute__((ext_vector_type(2)));template <int ACT  > struct EpiBf16 {
    static constexpr bool PERM = true, AFTER_DRAIN = false;
    bf16_t* O; int ldc;
    __device__ __forceinline__ void operator()(const f32x4 (&acc)[2][2][4][2], const Unit& u, int wr, int wc, int fr, int fq) const {
        const int row0 = u.pm * BM + wr * 64 + fr; const int col0 = u.pn * BM + wc * 32 + 8 * fq;
#pragma unroll
        for (int ai = 0; ai < 2; ++ai)
#pragma unroll
            for (int m = 0; m < 4; ++m) { bf16_t* rowp = O + (size_t)(row0 + ai * HALF + m * 16) * ldc + col0;
#pragma unroll
                for (int bj = 0; bj < 2; ++bj) { f32x4 v0 = acc[ai][bj][m][0], v1 = acc[ai][bj][m][1];
                    if (ACT == 2) {
#pragma unroll
                        for (int e = 0; e < 4; ++e) { float a = v0[e] > 0.f ? v0[e] : 0.f; v0[e] = a * a; float b = v1[e] > 0.f ? v1[e] : 0.f; v1[e] = b * b; } }
                    u32x4 w; w.x = cvt_pk_bf16(v0[0], v0[1]); w.y = cvt_pk_bf16(v0[2], v0[3]); w.z = cvt_pk_bf16(v1[0], v1[1]); w.w = cvt_pk_bf16(v1[2], v1[3]);
                    *(u32x4*)(rowp + bj * HALF) = w; } }
    }
};
template <class Epi, class Sched, bool ALIGN_EPI = false, bool SP2 = false>
__device__ __forceinline__ void gemm_phase(PG8_LAS unsigned char* lds, const Gemm g, const Sched& S, const Epi& E) {
    int tid_ = threadIdx.x; asm volatile("" : "+v"(tid_)); const int tid = tid_, wid = __builtin_amdgcn_readfirstlane(tid >> 6), lane = tid & 63, wr = wid >> 2, wc = wid & 3, fr = lane & 15, fq = lane >> 4;
    const int K = g.K, nt = K / BK;
    unsigned voffA[2], voffB[2];
#pragma unroll
    for (int i = 0; i < 2; ++i) { int R, C; stage_rc(tid * 16 + i * 8192, R, C); const int Rb = Epi::PERM ? ((R & ~31) + perm32(R & 31)) : R;
        voffA[i] = (unsigned)(R * K + C) * 2u; voffB[i] = (unsigned)(Rb * K + C) * 2u; }
    const size_t kstep = (size_t)(BK * 2);
    const size_t hstep = (size_t)HALF * K * 2;
    const size_t tstep = 2 * hstep;
    const unsigned ldsw = (unsigned)wid * 1024u;
    const int aoff = lds_byte(wr * 64 + fr, fq * 8), boff = lds_byte(wc * 32 + fr, fq * 8);
#define PG8_SA(b, h) (((b) * 2 + (h)) * HTB)
#define PG8_SB(b, h) ((4 + (b) * 2 + (h)) * HTB)
#define PG8_STAGE(bufoff, gbase, voff) do { _Pragma("unroll") for (int _i = 0; _i < 2; ++_i) \
        __builtin_amdgcn_global_load_lds((const unsigned*)((const char*)(gbase) + (voff)[_i]), (PG8_LAS unsigned*)(lds + (bufoff) + ldsw + _i * 8192), 16, 0, 0); } while (0)
#define PG8_LDA(dst, b, h) do { _Pragma("unroll") for (int m = 0; m < 4; ++m) _Pragma("unroll") for (int k = 0; k < 2; ++k) dst[m][k] = *(const PG8_LAS bf16x8*)(lds + PG8_SA(b, h) + aoff + m * 2048 + k * 1024); } while (0)
#define PG8_LDB(dst, b, h) do { _Pragma("unroll") for (int n = 0; n < 2; ++n) _Pragma("unroll") for (int k = 0; k < 2; ++k) dst[n][k] = *(const PG8_LAS bf16x8*)(lds + PG8_SB(b, h) + boff + n * 2048 + k * 1024); } while (0)
#define PG8_MMA(ai, bj, At, Bt) do { __builtin_amdgcn_s_setprio(1); _Pragma("unroll") for (int m = 0; m < 4; ++m) _Pragma("unroll") for (int n = 0; n < 2; ++n) _Pragma("unroll") for (int k = 0; k < 2; ++k) \
        acc[ai][bj][m][n] = __builtin_amdgcn_mfma_f32_16x16x32_bf16(Bt[n][k], At[m][k], acc[ai][bj][m][n], 0, 0, 0); __builtin_amdgcn_s_setprio(0); } while (0)
#define PG8_WAIT_V(n) asm volatile("s_waitcnt vmcnt(" #n ")" ::: "memory")
#define PG8_WAIT_L(n) asm volatile("s_waitcnt lgkmcnt(" #n ")" ::: "memory")
#define PG8_BAR __builtin_amdgcn_s_barrier()
#define PG8_SCHED __builtin_amdgcn_sched_barrier(0)
    Unit cur, nxt; int ui = 0;
    if (!S.next(0, cur)) return;
    f32x4 acc[2][2][4][2];
#pragma unroll
    for (int a = 0; a < 2; ++a)
#pragma unroll
        for (int b = 0; b < 2; ++b)
#pragma unroll
            for (int m = 0; m < 4; ++m)
#pragma unroll
                for (int n = 0; n < 2; ++n) acc[a][b][m][n] = (f32x4){0.f, 0.f, 0.f, 0.f};
    bf16x8 At[4][2], B0[2][2], B1[2][2];
    const char* cA = (const char*)g.A + (size_t)cur.pm * tstep; const char* cB = (const char*)g.Bt + (size_t)cur.pn * tstep;
    S.a_ready(cur);
    if constexpr (SP2) {
        PG8_STAGE(PG8_SB(0, 0), cB, voffB); PG8_STAGE(PG8_SB(0, 1), cB + hstep, voffB); PG8_STAGE(PG8_SA(0, 0), cA, voffA); PG8_STAGE(PG8_SA(0, 1), cA + hstep, voffA);
        if (wr == 1) PG8_BAR;
        PG8_WAIT_V(2); PG8_BAR;
        PG8_STAGE(PG8_SB(1, 0), cB + kstep, voffB); PG8_STAGE(PG8_SA(1, 0), cA + kstep, voffA); PG8_STAGE(PG8_SB(1, 1), cB + hstep + kstep, voffB);
        PG8_WAIT_V(6); PG8_BAR;
    } else {
        PG8_STAGE(PG8_SB(0, 0), cB, voffB); PG8_STAGE(PG8_SA(0, 0), cA, voffA); PG8_STAGE(PG8_SB(0, 1), cB + hstep, voffB); PG8_STAGE(PG8_SA(0, 1), cA + hstep, voffA);
        if (wr == 1) PG8_BAR;
        PG8_WAIT_V(4); PG8_BAR;
        PG8_STAGE(PG8_SB(1, 0), cB + kstep, voffB); PG8_STAGE(PG8_SA(1, 0), cA + kstep, voffA); PG8_STAGE(PG8_SB(1, 1), cB + hstep + kstep, voffB);
        PG8_WAIT_V(6); PG8_BAR;
    }
    for (;;) {
        const bool has_next = S.next(ui + 1, nxt);
        const char* nA = has_next ? (const char*)g.A + (size_t)nxt.pm * tstep : cA; const char* nB = has_next ? (const char*)g.Bt + (size_t)nxt.pn * tstep : cB;
        for (int t = 0; t < nt; t += 2) {
            const bool last = (t == nt - 2);
            const char* a1 = cA + (size_t)(t + 1) * kstep;
            const char* a2 = last ? nA : cA + (size_t)(t + 2) * kstep; const char* b2 = last ? nB : cB + (size_t)(t + 2) * kstep;
            const char* a3 = a2 + kstep; const char* b3 = b2 + kstep;
            if (last && has_next) S.a_ready(nxt);
            if constexpr (SP2) {
            PG8_LDB(B0, 0, 0); PG8_LDB(B1, 0, 1); PG8_SCHED; PG8_LDA(At, 0, 0); PG8_STAGE(PG8_SA(1, 1), a1 + hstep, voffA);
            PG8_WAIT_V(8); PG8_WAIT_L(0); PG8_BAR; PG8_MMA(0, 0, At, B0); PG8_MMA(0, 1, At, B1); PG8_BAR; PG8_SCHED;
            PG8_LDA(At, 0, 1); PG8_STAGE(PG8_SB(0, 0), b2, voffB); PG8_STAGE(PG8_SB(0, 1), b2 + hstep, voffB); PG8_STAGE(PG8_SA(0, 0), a2, voffA);
            PG8_WAIT_V(8); PG8_WAIT_L(0); PG8_BAR; PG8_MMA(1, 0, At, B0); PG8_MMA(1, 1, At, B1); PG8_BAR; PG8_SCHED;
            PG8_LDB(B0, 1, 0); PG8_LDB(B1, 1, 1); PG8_SCHED; PG8_LDA(At, 1, 0); PG8_STAGE(PG8_SA(0, 1), a2 + hstep, voffA);
            PG8_WAIT_V(8); PG8_WAIT_L(0); PG8_BAR; PG8_MMA(0, 0, At, B0); PG8_MMA(0, 1, At, B1); PG8_BAR; PG8_SCHED;
            PG8_LDA(At, 1, 1); PG8_STAGE(PG8_SB(1, 0), b3, voffB); PG8_STAGE(PG8_SB(1, 1), b3 + hstep, voffB); PG8_STAGE(PG8_SA(1, 0), a3, voffA);
            PG8_WAIT_V(8); PG8_WAIT_L(0); PG8_BAR; PG8_MMA(1, 0, At, B0); PG8_MMA(1, 1, At, B1); PG8_BAR; PG8_SCHED;
            } else {
            PG8_LDB(B0, 0, 0); PG8_SCHED; PG8_LDA(At, 0, 0); PG8_STAGE(PG8_SA(1, 1), a1 + hstep, voffA);
            PG8_WAIT_L(8); PG8_BAR; PG8_WAIT_L(0); PG8_MMA(0, 0, At, B0); PG8_BAR; PG8_SCHED;
            PG8_LDB(B1, 0, 1); PG8_STAGE(PG8_SB(0, 0), b2, voffB);
            PG8_BAR; PG8_WAIT_L(0); PG8_MMA(0, 1, At, B1); PG8_BAR;
            PG8_LDA(At, 0, 1); PG8_STAGE(PG8_SA(0, 0), a2, voffA);
            PG8_BAR; PG8_WAIT_L(0); PG8_MMA(1, 0, At, B0); PG8_BAR; PG8_SCHED;
            PG8_STAGE(PG8_SB(0, 1), b2 + hstep, voffB);
            PG8_WAIT_V(6); PG8_BAR; PG8_MMA(1, 1, At, B1); PG8_BAR;
            PG8_LDB(B0, 1, 0); PG8_SCHED; PG8_LDA(At, 1, 0); PG8_STAGE(PG8_SA(0, 1), a2 + hstep, voffA);
            PG8_WAIT_L(8); PG8_BAR; PG8_WAIT_L(0); PG8_MMA(0, 0, At, B0); PG8_BAR; PG8_SCHED;
            PG8_LDB(B1, 1, 1); PG8_STAGE(PG8_SB(1, 0), b3, voffB);
            PG8_BAR; PG8_WAIT_L(0); PG8_MMA(0, 1, At, B1); PG8_BAR;
            PG8_LDA(At, 1, 1); PG8_STAGE(PG8_SA(1, 0), a3, voffA);
            PG8_BAR; PG8_WAIT_L(0); PG8_MMA(1, 0, At, B0); PG8_BAR; PG8_SCHED;
            PG8_STAGE(PG8_SB(1, 1), b3 + hstep, voffB);
            PG8_WAIT_V(6); PG8_BAR; PG8_MMA(1, 1, At, B1); PG8_BAR;
            }
        }
        if constexpr (ALIGN_EPI) { if (wr == 0) PG8_BAR; }
        if constexpr (!Epi::AFTER_DRAIN) { E(acc, cur, wr, wc, fr, fq); S.done(cur); }
        if (!has_next) break;
#pragma unroll
        for (int a = 0; a < 2; ++a)
#pragma unroll
            for (int b = 0; b < 2; ++b)
#pragma unroll
                for (int m = 0; m < 4; ++m)
#pragma unroll
                    for (int n = 0; n < 2; ++n) acc[a][b][m][n] = (f32x4){0.f, 0.f, 0.f, 0.f};
        cur = nxt; cA = nA; cB = nB; ++ui;
        if constexpr (ALIGN_EPI) { if (wr == 1) PG8_BAR; }
    }
    PG8_WAIT_V(0);
    if constexpr (!ALIGN_EPI) { if (wr == 0) PG8_BAR; }
    PG8_BAR;
    if constexpr (Epi::AFTER_DRAIN) { E.fused(acc, cur, wr, wc, fr, fq, lds, wid, lane); S.done(cur); }
#undef PG8_SA
#undef PG8_SB
#undef PG8_STAGE
#undef PG8_LDA
#undef PG8_LDB
#undef PG8_MMA
#undef PG8_WAIT_V
#undef PG8_WAIT_L
#undef PG8_BAR
#undef PG8_SCHED
}
}
#define DI __device__ __forceinline__
#define LAS __attribute__((address_space(3)))
typedef unsigned short bf16;
typedef float f32x2v __attribute__((ext_vector_type(2)));
typedef float f32x4 __attribute__((ext_vector_type(4)));
typedef float f32x16 __attribute__((ext_vector_type(16)));
typedef short bf16x8 __attribute__((ext_vector_type(8)));
typedef short s16x4 __attribute__((ext_vector_type(4)));
typedef unsigned u32x4 __attribute__((ext_vector_type(4)));
typedef unsigned u32x2 __attribute__((ext_vector_type(2)));

constexpr int NB = 2, SEQ = 16384, CTXL = 256, DM = 1024, DEPTH = 2, INC = 2048, DFF = 4096;
constexpr int MLAT = NB * SEQ, MCTX = NB * CTXL, MTOT = MLAT + MCTX;
constexpr int SKV = CTXL + SEQ;
constexpr int NTILE64 = MTOT / 64;
constexpr int NCHUNK = SKV / 64;
constexpr float EPSN = 1e-6f;
constexpr int NTHR = 512, NWV = 8;
constexpr int LDS_BYTES = 147456;

constexpr size_t MiB = 1u << 20;
constexpr size_t WS_MOD = 1 * MiB;
constexpr size_t WS_POOLWT = 1 * MiB + 256 * 1024;
constexpr size_t WS_LRUWT = 1 * MiB + 384 * 1024;
constexpr size_t WS_WIN = 2 * MiB, WS_WOUT = 10 * MiB, WS_W1 = 14 * MiB, WS_W2 = 30 * MiB;
constexpr size_t WS_AGG = 46 * MiB;
constexpr size_t WS_CX = 49 * MiB;
constexpr size_t WS_H2 = 51 * MiB;
constexpr size_t WS_H2C = 59 * MiB;
constexpr size_t WS_W3T = 59 * MiB + 256 * 1024;
constexpr size_t WS_FTC = 60 * MiB;
constexpr size_t WS_QC = 61 * MiB;
constexpr size_t WS_XN = 62 * MiB;
constexpr size_t WS_MIX = 127 * MiB;
constexpr size_t WS_PX = 192 * MiB;
constexpr size_t WS_ZT = 322 * MiB;
constexpr size_t WS_ZTC = 370 * MiB;
constexpr size_t WS_Q = 371 * MiB;
constexpr size_t WS_K = 387 * MiB;
constexpr size_t WS_VT = 396 * MiB;
constexpr size_t WS_YDT = 405 * MiB;
constexpr size_t WS_YDTC = 421 * MiB;
constexpr size_t WS_FT = 422 * MiB;
constexpr size_t WS_CARRY = 486 * MiB;
constexpr size_t WS_END = 488 * MiB;

struct Args { const float* in[34]; float* out; unsigned char* ws; };

DI unsigned f2bf(float f) { unsigned u = __builtin_bit_cast(unsigned, f); return (u + 0x7fffu + ((u >> 16) & 1u)) >> 16; }
DI unsigned pk2(float lo, float hi) { return f2bf(lo) | (f2bf(hi) << 16); }
DI float bf2f(unsigned h) { return __builtin_bit_cast(float, h << 16); }
DI float bflo(unsigned w) { return __builtin_bit_cast(float, w << 16); }
DI float bfhi(unsigned w) { return __builtin_bit_cast(float, w & 0xffff0000u); }
DI float wave_sum(float v) {
#pragma unroll
    for (int o = 1; o < 64; o <<= 1) v += __shfl_xor(v, o);
    return v;
}
DI float sigmoidf_(float x) { return __builtin_amdgcn_rcpf(1.f + __expf(-x)); }
DI float gelu_tanh(float x) { const float u = 0.7978845608028654f * (x + 0.044715f * x * x * x); return x * __builtin_amdgcn_rcpf(1.f + __expf(-2.0f * u)); }
DI void unpack8(const u32x4 w, float* f) { f[0] = bflo(w.x); f[1] = bfhi(w.x); f[2] = bflo(w.y); f[3] = bfhi(w.y); f[4] = bflo(w.z); f[5] = bfhi(w.z); f[6] = bflo(w.w); f[7] = bfhi(w.w); }

struct Ctx {
    const float* const* in; float* out; unsigned char* ws; LAS unsigned char* lds;
    int tid, lane, wave, G, bid;
};
#define WSP(T, off) ((T*)(C.ws + (off)))
#define INP(i) (C.in[i])

DI void transpose_item(const float* W, int K, int N, bf16* WT, LAS float* scr, int item, int lane) {
    const int nblk = N / 32, kb = item / nblk, nb = item % nblk, k0 = 64 * kb, n0 = 32 * nb;
#pragma unroll
    for (int i = 0; i < 32; ++i) { const int kk = 2 * i + (lane >> 5); scr[kk * 33 + (lane & 31)] = W[(size_t)(k0 + kk) * N + n0 + (lane & 31)]; }
    asm volatile("s_waitcnt lgkmcnt(0)" ::: "memory");
    const int c = lane & 7;
#pragma unroll
    for (int j = 0; j < 4; ++j) { const int n = (lane >> 3) + 8 * j; const LAS float* s = scr + (8 * c) * 33 + n;
        u32x4 o; o.x = pk2(s[0 * 33], s[1 * 33]); o.y = pk2(s[2 * 33], s[3 * 33]); o.z = pk2(s[4 * 33], s[5 * 33]); o.w = pk2(s[6 * 33], s[7 * 33]);
        *(u32x4*)(WT + (size_t)(n0 + n) * K + k0 + 8 * c) = o; }
    asm volatile("s_waitcnt lgkmcnt(0)" ::: "memory");
}

DI void h2_item(Ctx& C, int l, int Lf, int t0, float* outp) {
    LAS float* emb = (LAS float*)C.lds;
    LAS float* h1s = emb + 64 * 33;
    LAS float* w1s = h1s + 64 * 65;
    LAS float* w2s = w1s + 33 * 64;
    const float* w1 = INP(25) + l * 33 * 64; const float* b1 = INP(26) + l * 64; const float* fq = INP(27) + l * 64;
    const float* w2 = INP(28) + l * 64 * 64; const float* b2 = INP(29) + l * 64;
    const int tid = C.tid;
#pragma unroll
    for (int i = 0; i < 5; ++i) { const int e = tid + NTHR * i; const float v = w1[e < 33 * 64 ? e : 0]; if (e < 33 * 64) w1s[e] = v; }
#pragma unroll
    for (int i = 0; i < 8; ++i) { const int e = tid + NTHR * i; w2s[e] = w2[e]; }
    for (int e = tid; e < 64 * 33; e += NTHR) { const int t2 = e / 33, i = e % 33, t = t0 + t2; float v;
        if (i == 0) v = (float)t / (float)(Lf - 1);
        else { const int bi = (i - 1) & 15; const float band = 1e-4f + (float)bi * ((15.0f - 1e-4f) / 15.0f);
            const float wv = (6.283185307179586f * (float)t) / (float)Lf; const float z = wv * band; v = (i <= 16) ? __cosf(z) : -__sinf(z); }
        emb[e] = v; }
    __syncthreads();
    const int tp = tid & 63, jg = tid >> 6;
    float a[8];
#pragma unroll
    for (int q = 0; q < 8; ++q) a[q] = b1[jg * 8 + q];
#pragma unroll 11
    for (int i = 0; i < 33; ++i) { const float ev = emb[tp * 33 + i];
#pragma unroll
        for (int q = 0; q < 8; ++q) a[q] += ev * w1s[i * 64 + jg * 8 + q]; }
#pragma unroll
    for (int q = 0; q < 8; ++q) h1s[tp * 65 + jg * 8 + q] = __sinf(fq[jg * 8 + q] * a[q]);
    __syncthreads();
#pragma unroll
    for (int q = 0; q < 8; ++q) a[q] = b2[jg * 8 + q];
#pragma unroll 8
    for (int i = 0; i < 64; ++i) { const float hv = h1s[tp * 65 + i];
#pragma unroll
        for (int q = 0; q < 8; ++q) a[q] += hv * w2s[i * 64 + jg * 8 + q]; }
    float o[8];
#pragma unroll
    for (int q = 0; q < 8; ++q) o[q] = __sinf(fq[jg * 8 + q] * a[q]);
    float* dst = outp + (size_t)(t0 + tp) * 64 + jg * 8;
    *(f32x4*)dst = (f32x4){o[0], o[1], o[2], o[3]}; *(f32x4*)(dst + 4) = (f32x4){o[4], o[5], o[6], o[7]};
    __syncthreads();
}

DI void phase0(Ctx& C) {
    const int gw = C.bid * NWV + C.wave, NGW = C.G * NWV;
    {
        LAS float* scr = (LAS float*)(C.lds + C.wave * 16384);
        constexpr int I_IN = 16 * 64, I_OUT = 16 * 32, I_1 = 16 * 128, I_2 = 64 * 32, PER = I_IN + I_OUT + I_1 + I_2;
        for (int it = gw; it < 2 * PER; it += NGW) {
            const int l = it / PER; int r = it % PER;
            if (r < I_IN) { transpose_item(INP(10) + (size_t)l * DM * INC, DM, INC, WSP(bf16, WS_WIN) + (size_t)l * INC * DM, scr, r, C.lane); continue; } r -= I_IN;
            if (r < I_OUT) { transpose_item(INP(11) + (size_t)l * DM * DM, DM, DM, WSP(bf16, WS_WOUT) + (size_t)l * DM * DM, scr, r, C.lane); continue; } r -= I_OUT;
            if (r < I_1) { transpose_item(INP(32) + (size_t)l * DM * DFF, DM, DFF, WSP(bf16, WS_W1) + (size_t)l * DFF * DM, scr, r, C.lane); continue; } r -= I_1;
            transpose_item(INP(33) + (size_t)l * DFF * DM, DFF, DM, WSP(bf16, WS_W2) + (size_t)l * DM * DFF, scr, r, C.lane);
        }
    }
    {
        const int gt = C.bid * NTHR + C.tid, NGT = C.G * NTHR;
        for (int e = gt; e < 2 * 4 * 4096; e += NGT) { const int m = e >> 12, n = (e >> 6) & 63, k = e & 63; WSP(bf16, WS_POOLWT)[e] = (bf16)f2bf(INP(12)[m * 4096 + k * 64 + n]); }
        for (int e = gt; e < 2 * 2 * 2 * 4 * 4096; e += NGT) {
            const int k = e & 63, n = (e >> 6) & 63, blk = (e >> 12) & 3, which = (e >> 14) & 1, d = (e >> 15) & 1, l = e >> 16;
            const float* src = which ? INP(20) : INP(18);
            WSP(bf16, WS_LRUWT)[e] = (bf16)f2bf(src[(((l * 2 + d) * 4 + blk) * 64 + k) * 64 + n]); }
        for (int e = gt; e < 2 * 65536; e += NGT) { const int k = e & 63, col = (e >> 6) & 1023, l = e >> 16; WSP(float, WS_W3T)[e] = INP(30)[(l * 64 + k) * 1024 + col]; }
    }
    __syncthreads();
    {
        LAS float* sc = (LAS float*)C.lds;
        LAS float* red = sc + 3 * 1024;
        for (int e = C.tid; e < 3 * 1024; e += NTHR) { const int i = e >> 10, k = e & 1023; const float v = (i < 2) ? INP(1)[i * 1024 + k] : INP(3)[k]; sc[e] = v / (1.f + __expf(-v)); }
        __syncthreads();
        for (int it = C.bid; it < 192; it += C.G) {
            const int l = it / 96, j = (it % 96) * 64 + C.lane; const float* wm = INP(4) + (size_t)l * DM * 6144 + j;
            float a0 = 0.f, a1 = 0.f, a2 = 0.f; const int kb = C.wave * 128;
#pragma unroll 32
            for (int k = kb; k < kb + 128; ++k) { const float w = wm[(size_t)k * 6144]; a0 += sc[k] * w; a1 += sc[1024 + k] * w; a2 += sc[2048 + k] * w; }
            red[(C.wave * 3 + 0) * 64 + C.lane] = a0; red[(C.wave * 3 + 1) * 64 + C.lane] = a1; red[(C.wave * 3 + 2) * 64 + C.lane] = a2;
            __syncthreads();
            if (C.tid < 192) { const int i = C.tid >> 6, ln = C.tid & 63; float s = 0.f;
                for (int w = 0; w < 8; ++w) s += red[(w * 3 + i) * 64 + ln];
                const int jj = (it % 96) * 64 + ln; WSP(float, WS_MOD)[(l * 3 + i) * 6144 + jj] = s + INP(5)[l * 6144 + jj]; }
            __syncthreads();
        }
    }
    for (int it = C.bid; it < 2 * 256 + 4; it += C.G) {
        if (it < 512) { const int l = it >> 8; h2_item(C, l, SEQ, (it & 255) * 64, WSP(float, WS_H2) + (size_t)l * SEQ * 64); }
        else h2_item(C, 0, CTXL, (it - 512) * 64, WSP(float, WS_H2C));
    }
}

DI int row_cond(int m) { return m < MLAT ? (m >> 14) : 2; }
DI void row_norm_mod(const float* xr, const float* g, const float* shift, const float* scale, bf16* xn, int lane) {
    f32x4 v[4]; float s = 0.f;
#pragma unroll
    for (int j = 0; j < 4; ++j) { v[j] = *(const f32x4*)(xr + 4 * lane + 256 * j); s += (v[j].x * v[j].x + v[j].y * v[j].y) + (v[j].z * v[j].z + v[j].w * v[j].w); }
    const float r = rsqrtf(wave_sum(s) * (1.f / DM) + EPSN);
#pragma unroll
    for (int j = 0; j < 4; ++j) { const int c = 4 * lane + 256 * j; const f32x4 gg = *(const f32x4*)(g + c), sh = *(const f32x4*)(shift + c), sc = *(const f32x4*)(scale + c);
        f32x4 o; o = (v[j] * r * gg) * (sc + 1.0f) + sh;
        u32x2 w; w.x = pk2(o.x, o.y); w.y = pk2(o.z, o.w); *(u32x2*)(xn + c) = w; }
}
template <int NR> DI void row_norm_mod_n(const float* const (&xr)[NR], const LAS float* g, const LAS float* shift, const LAS float* scale, bf16* const (&xn)[NR], int lane) {
    f32x4 v[NR][4]; float s[NR];
#pragma unroll
    for (int q = 0; q < NR; ++q) { s[q] = 0.f;
#pragma unroll
        for (int j = 0; j < 4; ++j) { v[q][j] = *(const f32x4*)(xr[q] + 4 * lane + 256 * j); s[q] += (v[q][j].x * v[q][j].x + v[q][j].y * v[q][j].y) + (v[q][j].z * v[q][j].z + v[q][j].w * v[q][j].w); } }
#pragma unroll
    for (int q = 0; q < NR; ++q) { const float r = rsqrtf(wave_sum(s[q]) * (1.f / DM) + EPSN);
#pragma unroll
        for (int j = 0; j < 4; ++j) { const int c = 4 * lane + 256 * j; const f32x4 gg = *(const LAS f32x4*)(g + c), sh = *(const LAS f32x4*)(shift + c), sc = *(const LAS f32x4*)(scale + c);
            const f32x4 o = (v[q][j] * r * gg) * (sc + 1.0f) + sh; u32x2 w; w.x = pk2(o.x, o.y); w.y = pk2(o.z, o.w); *(u32x2*)(xn[q] + c) = w; } }
}
template <int NR> DI void row_update(const float* const (&xi)[NR], const bf16* const (&y)[NR], const LAS float* gpost, const LAS float* gate, float* const (&xo)[NR], const LAS float* gnext, const LAS float* shift, const LAS float* scale, bf16* const (&xn)[NR], bool donext, int lane) {
    f32x4 yv[NR][4], xv[NR][4]; float s[NR];
#pragma unroll
    for (int q = 0; q < NR; ++q) { s[q] = 0.f;
#pragma unroll
        for (int j = 0; j < 4; ++j) { const u32x2 w = *(const u32x2*)(y[q] + 4 * lane + 256 * j); yv[q][j] = (f32x4){bflo(w.x), bfhi(w.x), bflo(w.y), bfhi(w.y)}; xv[q][j] = *(const f32x4*)(xi[q] + 4 * lane + 256 * j);
            s[q] += (yv[q][j].x * yv[q][j].x + yv[q][j].y * yv[q][j].y) + (yv[q][j].z * yv[q][j].z + yv[q][j].w * yv[q][j].w); } }
    float s2[NR];
#pragma unroll
    for (int q = 0; q < NR; ++q) { const float r = rsqrtf(wave_sum(s[q]) * (1.f / DM) + EPSN); s2[q] = 0.f;
#pragma unroll
        for (int j = 0; j < 4; ++j) { const int c = 4 * lane + 256 * j; const f32x4 gp = *(const LAS f32x4*)(gpost + c), ga = *(const LAS f32x4*)(gate + c);
            xv[q][j] = xv[q][j] + ga * (yv[q][j] * r * gp); *(f32x4*)(xo[q] + c) = xv[q][j];
            s2[q] += (xv[q][j].x * xv[q][j].x + xv[q][j].y * xv[q][j].y) + (xv[q][j].z * xv[q][j].z + xv[q][j].w * xv[q][j].w); } }
    if (donext) {
#pragma unroll
        for (int q = 0; q < NR; ++q) { const float r2 = rsqrtf(wave_sum(s2[q]) * (1.f / DM) + EPSN);
#pragma unroll
            for (int j = 0; j < 4; ++j) { const int c = 4 * lane + 256 * j; const f32x4 gg = *(const LAS f32x4*)(gnext + c), sh = *(const LAS f32x4*)(shift + c), sc = *(const LAS f32x4*)(scale + c);
                const f32x4 o = (xv[q][j] * r2 * gg) * (sc + 1.0f) + sh; u32x2 w; w.x = pk2(o.x, o.y); w.y = pk2(o.z, o.w); *(u32x2*)(xn[q] + c) = w; } }
    }
}

DI void ft_item(Ctx& C, const float* H2, const float* W3T, float* FT, int Lf, int n0) {
    LAS float* wl = (LAS float*)C.lds;
    const int n = n0 + C.lane; float h[64];
#pragma unroll
    for (int i = 0; i < 16; ++i) { const f32x4 v = *(const f32x4*)(H2 + (size_t)n * 64 + 4 * i); h[4 * i] = v.x; h[4 * i + 1] = v.y; h[4 * i + 2] = v.z; h[4 * i + 3] = v.w; }
    const float t01 = (float)n / (float)(Lf - 1);
    const int wv = __builtin_amdgcn_readfirstlane(C.wave);
#pragma unroll 1
    for (int half = 0; half < 2; ++half) {
        __syncthreads();
#pragma unroll 16
        for (int e = C.tid; e < 512 * 16; e += NTHR) *(LAS f32x4*)(wl + 4 * e) = *(const f32x4*)(W3T + (size_t)half * 32768 + 4 * e);
        __syncthreads();
#pragma unroll 2
        for (int ci = 0; ci < 64; ++ci) {
            const int cl = wv * 64 + ci, col = half * 512 + cl; const LAS float* wc = wl + cl * 64; float a = 0.f;
#pragma unroll
            for (int k4 = 0; k4 < 16; ++k4) { const f32x4 w4 = *(const LAS f32x4*)(wc + 4 * k4); a += h[4 * k4] * w4.x; a += h[4 * k4 + 1] * w4.y; a += h[4 * k4 + 2] * w4.z; a += h[4 * k4 + 3] * w4.w; }
            const int c = col & 255, o = (col >> 8) & 1, dir = col >> 9;
            const float delta = 3.0701134573253944f + (float)c * ((15.350567286626972f - 3.0701134573253944f) / 255.0f);
            FT[(size_t)((o * 2 + dir) * 256 + c) * Lf + n] = a * __expf(-t01 * delta);
        }
    }
    __syncthreads();
}
struct Tile { int b, p0, Ls, m0, lat; };
DI Tile tile_of(int tt) { Tile t; if (tt < 512) { t.lat = 1; t.b = tt >> 8; t.p0 = (tt & 255) * 64; t.Ls = SEQ; t.m0 = t.b * SEQ + t.p0; } else { const int u = tt - 512; t.lat = 0; t.b = u >> 2; t.p0 = (u & 3) * 64; t.Ls = CTXL; t.m0 = MLAT + t.b * CTXL + t.p0; } return t; }

DI void head_norm_rope(const bf16* src, const float* g, int a, int pos, bool rope, float oscale, bf16* dst) {
    float v[32];
#pragma unroll
    for (int i = 0; i < 4; ++i) unpack8(*(const u32x4*)(src + 8 * i), v + 8 * i);
    float ss = 0.f;
#pragma unroll
    for (int i = 0; i < 32; ++i) ss += v[i] * v[i];
    ss += __shfl_xor(ss, 1);
    const float r = rsqrtf(ss * (1.f / 64.f) + EPSN);
#pragma unroll
    for (int i = 0; i < 32; ++i) v[i] = v[i] * r * g[a * 32 + i];
    if (rope) {
        const float coord = (float)(a == 0 ? (pos >> 6) : (pos & 63));
#pragma unroll
        for (int f = 0; f < 16; ++f) { const float inv = exp2f(-(float)f * (13.287712379549449f / 16.0f)); const float ang = coord * inv; const float sn = __sinf(ang), cs = __cosf(ang);
            const float t1 = v[f], t2 = v[16 + f]; v[f] = t1 * cs - t2 * sn; v[16 + f] = t2 * cs + t1 * sn; }
    }
#pragma unroll
    for (int i = 0; i < 4; ++i) { u32x4 w; w.x = pk2(v[8 * i] * oscale, v[8 * i + 1] * oscale); w.y = pk2(v[8 * i + 2] * oscale, v[8 * i + 3] * oscale); w.z = pk2(v[8 * i + 4] * oscale, v[8 * i + 5] * oscale); w.w = pk2(v[8 * i + 6] * oscale, v[8 * i + 7] * oscale);
        *(u32x4*)(dst + 8 * i) = w; }
}

DI void prep_qkv(Ctx& C, int l, const Tile& T) {
    const bf16* PX = WSP(bf16, WS_PX); int tid = C.tid; asm volatile("" : "+v"(tid));
    LAS bf16* vs = (LAS bf16*)C.lds;
    {
        const int tok = tid >> 3, part = tid & 7, head = part >> 1, a = part & 1, pos = T.p0 + tok;
        const bf16* src = PX + (size_t)(T.m0 + tok) * INC + 256 + head * 64 + a * 32;
        bf16* dst = T.lat ? WSP(bf16, WS_Q) + ((size_t)(T.b * 4 + head) * SEQ + pos) * 64 + a * 32 : WSP(bf16, WS_QC) + ((size_t)(T.b * 4 + head) * CTXL + pos) * 64 + a * 32;
        head_norm_rope(src, INP(14) + l * 64, a, pos, T.lat != 0, 0.125f * 1.4426950408889634f, dst);
    }
    if (tid < 256) {
        const int tok = tid >> 2, part = tid & 3, head = part >> 1, a = part & 1, pos = T.p0 + tok;
        const bf16* src = PX + (size_t)(T.m0 + tok) * INC + 512 + head * 64 + a * 32;
        bf16* dst = WSP(bf16, WS_K) + ((size_t)(T.b * 2 + head) * SKV + (T.lat ? CTXL + pos : pos)) * 64 + a * 32;
        head_norm_rope(src, INP(15) + l * 64, a, pos, T.lat != 0, 1.0f, dst);
    } else {
        const int u = tid - 256;
#pragma unroll
        for (int i = 0; i < 4; ++i) { const int e = u + 256 * i, tok = e >> 4, ch = e & 15;
            const u32x4 w = *(const u32x4*)(PX + (size_t)(T.m0 + tok) * INC + 640 + ch * 8);
            *(LAS u32x4*)(vs + tok * 136 + ch * 8) = w; }
    }
    __syncthreads();
#pragma unroll
    for (int i = 0; i < 2; ++i) { const int task = tid + 512 * i, d = task >> 3, chunk = task & 7; unsigned short e[8];
#pragma unroll
        for (int j = 0; j < 8; ++j) e[j] = vs[(chunk * 8 + j) * 136 + d];
        u32x4 w; w.x = e[0] | ((unsigned)e[1] << 16); w.y = e[2] | ((unsigned)e[3] << 16); w.z = e[4] | ((unsigned)e[5] << 16); w.w = e[6] | ((unsigned)e[7] << 16);
        const int kvh = d >> 6, dd = d & 63;
        *(u32x4*)(WSP(bf16, WS_VT) + ((size_t)(T.b * 2 + kvh) * 64 + dd) * SKV + (T.lat ? CTXL + T.p0 : T.p0) + chunk * 8) = w; }
    __syncthreads();
}

DI void prep_hyena(Ctx& C, int l, const Tile& T, int gsel) {
    const bf16* PX = WSP(bf16, WS_PX); int tid = C.tid; asm volatile("" : "+v"(tid));
    LAS bf16* ts = (LAS bf16*)C.lds;
    {
        u32x4 w[5];
#pragma unroll
        for (int i = 0; i < 5; ++i) { const int e0 = tid + 512 * i, e = e0 < 66 * 32 ? e0 : 66 * 32 - 1; const int r = e >> 5, ch = e & 31, p = T.p0 - 1 + r; const bool ok = (p >= 0 && p < T.Ls); const int pc = ok ? p : T.p0;
            w[i] = *(const u32x4*)(PX + (size_t)(T.m0 - T.p0 + pc) * INC + 1280 + gsel * 256 + ch * 8); if (!ok) w[i] = (u32x4){0u, 0u, 0u, 0u}; }
#pragma unroll
        for (int i = 0; i < 5; ++i) { const int e = tid + 512 * i; if (e < 66 * 32) *(LAS u32x4*)(ts + (e >> 5) * 264 + (e & 31) * 8) = w[i]; }
    }
    __syncthreads();
    const float* cw = INP(23) + l * 3 * 768; const float* cb = INP(24) + l * 768;
#pragma unroll
    for (int i = 0; i < 4; ++i) { const int task = tid + 512 * i, col = task & 255, chunk = task >> 8, ci = gsel * 256 + col;
        const float w0 = cw[ci], w1 = cw[768 + ci], w2 = cw[1536 + ci], bb = cb[ci]; float x[10];
#pragma unroll
        for (int j = 0; j < 10; ++j) x[j] = bf2f(ts[(chunk * 8 + j) * 264 + col]);
        float o[8];
#pragma unroll
        for (int j = 0; j < 8; ++j) o[j] = bb + w0 * x[j] + w1 * x[j + 1] + w2 * x[j + 2];
        u32x4 w; w.x = pk2(o[0], o[1]); w.y = pk2(o[2], o[3]); w.z = pk2(o[4], o[5]); w.w = pk2(o[6], o[7]);
        bf16* dst = T.lat ? WSP(bf16, WS_ZT) + ((size_t)(T.b * 768 + ci)) * SEQ + T.p0 + chunk * 8 : WSP(bf16, WS_ZTC) + ((size_t)(T.b * 768 + ci)) * CTXL + T.p0 + chunk * 8;
        *(u32x4*)dst = w; }
    __syncthreads();
}

DI void prep_pool(Ctx& C, int l, const Tile& T) {
    const bf16* PX = WSP(bf16, WS_PX); int tid = C.tid; asm volatile("" : "+v"(tid));
    LAS float* us = (LAS float*)C.lds;
    LAS bf16* dt = (LAS bf16*)(C.lds + 80 * 256 * 4);
    {
        u32x4 w[5];
#pragma unroll
        for (int i = 0; i < 5; ++i) { const int e = tid + 512 * i, r = e >> 5, ch = e & 31, p = T.p0 - 8 + r; const bool ok = (p >= 0 && p < T.Ls); const int pc = ok ? p : T.p0;
            w[i] = *(const u32x4*)(PX + (size_t)(T.m0 - T.p0 + pc) * INC + ch * 8); if (!ok) w[i] = (u32x4){0u, 0u, 0u, 0u}; }
#pragma unroll
        for (int i = 0; i < 5; ++i) { const int e = tid + 512 * i, r = e >> 5, ch = e & 31; float f[8]; unpack8(w[i], f);
#pragma unroll
            for (int j = 0; j < 8; ++j) us[r * 256 + ch * 8 + j] = f[j]; }
    }
    __syncthreads();
    {
        const int col = tid & 255, th = tid >> 8, g = col >> 6, half = 1 << g;
        const int j0 = th * 32; float s = 0.f;
        for (int q = j0 - half; q < j0 + half; ++q) s += us[(q + 8) * 256 + col];
#pragma unroll 4
        for (int j = j0; j < j0 + 32; ++j) {
            const int p = T.p0 + j; int lo = p - half; if (lo < 0) lo = 0; int hi = p + half; if (hi > T.Ls) hi = T.Ls;
            const float d = s * __builtin_amdgcn_rcpf((float)(hi - lo)) - us[(j + 8) * 256 + col];
            dt[j * 264 + col] = (bf16)f2bf(d);
            s += us[(j + half + 8) * 256 + col] - us[(j - half + 8) * 256 + col];
        }
    }
    __syncthreads();
    {
        const int w = C.wave, g = w >> 1, th = w & 1, lane = tid & 63, rr = lane & 15, quad = lane >> 4;
        const bf16* WT = WSP(bf16, WS_POOLWT) + (size_t)(l * 4 + g) * 4096;
        bf16x8 af[2][2];
#pragma unroll
        for (int mt = 0; mt < 2; ++mt)
#pragma unroll
            for (int ks = 0; ks < 2; ++ks) af[mt][ks] = *(const LAS bf16x8*)(dt + (th * 32 + mt * 16 + rr) * 264 + g * 64 + ks * 32 + quad * 8);
#pragma unroll
        for (int nt = 0; nt < 4; ++nt) {
            bf16x8 bfr[2];
#pragma unroll
            for (int ks = 0; ks < 2; ++ks) bfr[ks] = *(const bf16x8*)(WT + (nt * 16 + rr) * 64 + ks * 32 + quad * 8);
            const int oc = g * 64 + nt * 16 + rr; const float psc = INP(13)[l * 256 + oc];
#pragma unroll
            for (int mt = 0; mt < 2; ++mt) { f32x4 acc = (f32x4){0.f, 0.f, 0.f, 0.f};
#pragma unroll
                for (int ks = 0; ks < 2; ++ks) acc = __builtin_amdgcn_mfma_f32_16x16x32_bf16(af[mt][ks], bfr[ks], acc, 0, 0, 0);
#pragma unroll
                for (int j = 0; j < 4; ++j) { const int tok = th * 32 + mt * 16 + quad * 4 + j; WSP(bf16, WS_MIX)[(size_t)(T.m0 + tok) * DM + oc] = (bf16)f2bf(acc[j] * psc); } }
        }
    }
    __syncthreads();
}

template <int PH> DI void lru_item(Ctx& C, int l, const Tile& T, int nb) {
    const bf16* PX = WSP(bf16, WS_PX); int tid = C.tid; asm volatile("" : "+v"(tid)); const int lane = tid & 63;
    LAS float* xcf = (LAS float*)C.lds;
    LAS bf16* xcb = (LAS bf16*)(C.lds + 64 * 65 * 4);
    LAS float* as_ = (LAS float*)(C.lds + 32768);
    LAS float* bs_ = as_ + 2 * 64 * 64;
    {
        const int tok = tid >> 3, c8 = tid & 7, p = T.p0 + tok, ch0 = nb * 64 + c8 * 8; float acc[8];
        const float* cw = INP(16) + l * 4 * 256; const float* cb = INP(17) + l * 256;
#pragma unroll
        for (int j = 0; j < 8; ++j) acc[j] = cb[ch0 + j];
#pragma unroll
        for (int k = 0; k < 4; ++k) { const int q = p + k - 2;
            if (q >= 0 && q < T.Ls) { float f[8]; unpack8(*(const u32x4*)(PX + (size_t)(T.m0 - T.p0 + q) * INC + 768 + ch0), f);
#pragma unroll
                for (int j = 0; j < 8; ++j) acc[j] += cw[k * 256 + ch0 + j] * f[j]; } }
#pragma unroll
        for (int j = 0; j < 8; ++j) xcf[tok * 65 + c8 * 8 + j] = acc[j];
        u32x4 w; w.x = pk2(acc[0], acc[1]); w.y = pk2(acc[2], acc[3]); w.z = pk2(acc[4], acc[5]); w.w = pk2(acc[6], acc[7]);
        *(LAS u32x4*)(xcb + tok * 72 + c8 * 8) = w;
    }
    __syncthreads();
    {
        const int w = C.wave, dir = w >> 2, tq = w & 3, rr = lane & 15, quad = lane >> 4;
        bf16x8 af[2];
#pragma unroll
        for (int ks = 0; ks < 2; ++ks) af[ks] = *(const LAS bf16x8*)(xcb + (tq * 16 + rr) * 72 + ks * 32 + quad * 8);
        const bf16* WA = WSP(bf16, WS_LRUWT) + (size_t)((((l * 2 + dir) * 2 + 0) * 4 + nb)) * 4096;
        const bf16* WX = WSP(bf16, WS_LRUWT) + (size_t)((((l * 2 + dir) * 2 + 1) * 4 + nb)) * 4096;
#pragma unroll
        for (int nt = 0; nt < 4; ++nt) {
            f32x4 ar = (f32x4){0.f, 0.f, 0.f, 0.f}, ai = (f32x4){0.f, 0.f, 0.f, 0.f};
#pragma unroll
            for (int ks = 0; ks < 2; ++ks) { const bf16x8 ba = *(const bf16x8*)(WA + (nt * 16 + rr) * 64 + ks * 32 + quad * 8), bx = *(const bf16x8*)(WX + (nt * 16 + rr) * 64 + ks * 32 + quad * 8);
                ar = __builtin_amdgcn_mfma_f32_16x16x32_bf16(af[ks], ba, ar, 0, 0, 0); ai = __builtin_amdgcn_mfma_f32_16x16x32_bf16(af[ks], bx, ai, 0, 0, 0); }
            const int chl = nt * 16 + rr, ch = nb * 64 + chl; const int pi = (l * 2 + dir) * 256 + ch;
            const float br = INP(19)[pi], bi = INP(21)[pi], lam = INP(22)[pi]; const float sp = log1pf(__expf(-lam));
#pragma unroll
            for (int j = 0; j < 4; ++j) { const int tok = tq * 16 + quad * 4 + j;
                const float r = sigmoidf_(ar[j] + br), ig = sigmoidf_(ai[j] + bi); const float la = -8.0f * r * sp; const float a = __expf(la);
                const float bcoef = __builtin_amdgcn_sqrtf(fmaxf(-expm1f(2.0f * la), 0.f)) * (ig * xcf[tok * 65 + chl]);
                as_[(dir * 64 + tok) * 64 + chl] = a; bs_[(dir * 64 + tok) * 64 + chl] = bcoef; }
        }
    }
    __syncthreads();
    const int cid = T.lat ? 4 + (T.p0 >> 6) : (T.p0 >> 6);
    float* AGG = WSP(float, WS_AGG);
    if (tid < 128) {
        const int dir = tid >> 6, chl = tid & 63, ch = nb * 64 + chl; float h = 0.f;
        if (PH == 2) h = WSP(float, WS_CARRY)[(size_t)(T.b * NCHUNK + cid) * 512 + dir * 256 + ch];
        float A = 1.f;
        if (dir == 0) {
#pragma unroll 16
            for (int t = 0; t < 64; ++t) { const float a = as_[(dir * 64 + t) * 64 + chl], b = bs_[(dir * 64 + t) * 64 + chl]; h = a * h + b; A *= a; if (PH == 2) bs_[(dir * 64 + t) * 64 + chl] = h; } }
        else {
#pragma unroll 16
            for (int t = 63; t >= 0; --t) { const float a = as_[(dir * 64 + t) * 64 + chl], b = bs_[(dir * 64 + t) * 64 + chl]; h = a * h + b; A *= a; if (PH == 2) bs_[(dir * 64 + t) * 64 + chl] = h; } }
        if (PH == 1) { float* ag = AGG + ((size_t)(T.b * NCHUNK + cid) * 2 + dir) * 512 + ch; ag[0] = A; ag[256] = h; }
    }
    __syncthreads();
    if (PH == 2) {
        const int tok = tid >> 3, c8 = tid & 7, ch0 = nb * 64 + c8 * 8; float g[8], o[8];
        unpack8(*(const u32x4*)(PX + (size_t)(T.m0 + tok) * INC + 1024 + ch0), g);
#pragma unroll
        for (int j = 0; j < 8; ++j) o[j] = (bs_[tok * 64 + c8 * 8 + j] + bs_[(64 + tok) * 64 + c8 * 8 + j]) * gelu_tanh(g[j]);
        u32x4 w; w.x = pk2(o[0], o[1]); w.y = pk2(o[2], o[3]); w.z = pk2(o[4], o[5]); w.w = pk2(o[6], o[7]);
        *(u32x4*)(WSP(bf16, WS_MIX) + (size_t)(T.m0 + tok) * DM + 512 + ch0) = w;
        __syncthreads();
    }
}

DI void lru_carry(Ctx& C) {
    if (C.bid >= 16) return;
    const int b = C.bid >> 3, dir = (C.bid >> 2) & 1, ch = (C.bid & 3) * 64 + C.lane, w = C.wave;
    const float* ag = WSP(float, WS_AGG) + (size_t)b * NCHUNK * 1024 + dir * 512 + ch;
    float* cr = WSP(float, WS_CARRY) + (size_t)b * NCHUNK * 512 + dir * 256 + ch;
    LAS float* sa = (LAS float*)C.lds; LAS float* sb = sa + 8 * 64;
    constexpr int SEG = 33;
    const int s0 = w * SEG; float a[SEG], bq[SEG];
#pragma unroll
    for (int i = 0; i < SEG; ++i) { const int s = s0 + i; const int cid = dir == 0 ? s : (s < 4 ? 3 - s : NCHUNK + 3 - s);
        if (s < NCHUNK) { a[i] = ag[(size_t)cid * 1024]; bq[i] = ag[(size_t)cid * 1024 + 256]; } else { a[i] = 1.f; bq[i] = 0.f; } }
    float A = 1.f, B = 0.f;
#pragma unroll
    for (int i = 0; i < SEG; ++i) { B = a[i] * B + bq[i]; A *= a[i]; }
    sa[w * 64 + C.lane] = A; sb[w * 64 + C.lane] = B;
    __syncthreads();
    float h = 0.f;
    for (int w2 = 0; w2 < w; ++w2) h = sa[w2 * 64 + C.lane] * h + sb[w2 * 64 + C.lane];
#pragma unroll
    for (int i = 0; i < SEG; ++i) { const int s = s0 + i; const int cid = dir == 0 ? s : (s < 4 ? 3 - s : NCHUNK + 3 - s);
        if (s < NCHUNK) { cr[(size_t)cid * 512] = h; h = a[i] * h + bq[i]; } }
    __syncthreads();
}
DI float max3f(float a, float b, float c) { float r; asm("v_max3_f32 %0, %1, %2, %3" : "=v"(r) : "v"(a), "v"(b), "v"(c)); return r; }
DI int crow(int r, int hi) { return (r & 3) + 8 * (r >> 2) + 4 * hi; }
DI unsigned cvtpk(float lo, float hi) { typedef __bf16 bf16x2_t __attribute__((ext_vector_type(2))); f32x2v v = {lo, hi}; bf16x2_t b = __builtin_convertvector(v, bf16x2_t); return __builtin_bit_cast(unsigned, b); }
DI void attn_unit(Ctx& C, const bf16* Qp, const bf16* Kp, const bf16* VTp, int NT, bf16* Op, int q0, int nrows) {
    int tid = C.tid; asm volatile("" : "+v"(tid)); const int lane = tid & 63, w = C.wave, r = lane & 31, hi = lane >> 5;
    LAS unsigned char* Ks = C.lds;
    LAS unsigned char* Vs = C.lds + 2 * 9216;
    LAS float* wsf = (LAS float*)(C.lds + 4 * 9216) + w * 64;
    bf16x8 qf[2][4];
#pragma unroll
    for (int g = 0; g < 2; ++g)
#pragma unroll
        for (int d0 = 0; d0 < 4; ++d0) qf[g][d0] = *(const bf16x8*)(Qp + (size_t)(q0 + w * 64 + g * 32 + r) * 64 + d0 * 16 + hi * 8);
    const int srow = tid >> 3, sch = tid & 7;
    u32x4 kreg = *(const u32x4*)(Kp + (size_t)tid * 8);
    u32x4 vreg = *(const u32x4*)(VTp + (size_t)srow * SKV + sch * 8);
    *(LAS u32x4*)(Ks + srow * 144 + sch * 16) = kreg; *(LAS u32x4*)(Vs + srow * 144 + sch * 16) = vreg;
    __syncthreads();
    f32x16 o[2][2];
#pragma unroll
    for (int g = 0; g < 2; ++g)
#pragma unroll
        for (int i = 0; i < 16; ++i) { o[g][0][i] = 0.f; o[g][1][i] = 0.f; }
    float m[2] = {0.f, 0.f}, lsum[2] = {0.f, 0.f};
    bool anym = false;
    for (int t = 0; t < NT; ++t) {
        const int cur = t & 1; const bool more = (t + 1 < NT);
        if (more) { kreg = *(const u32x4*)(Kp + (size_t)(t + 1) * 4096 + (size_t)tid * 8); vreg = *(const u32x4*)(VTp + (size_t)srow * SKV + (t + 1) * 64 + sch * 8); }
        const LAS unsigned char* kb = Ks + cur * 9216 + r * 144 + hi * 16;
        const LAS unsigned char* vb = Vs + cur * 9216 + r * 144 + hi * 8;
        f32x16 p[2][2]; u32x4 pa[2][2][2]; bf16x8 kf[2][4];
        const f32x16 z = {0.f, 0.f, 0.f, 0.f, 0.f, 0.f, 0.f, 0.f, 0.f, 0.f, 0.f, 0.f, 0.f, 0.f, 0.f, 0.f};
#pragma unroll
        for (int d0 = 0; d0 < 4; ++d0) { kf[0][d0] = *(const LAS bf16x8*)(kb + d0 * 32); kf[1][d0] = *(const LAS bf16x8*)(kb + 32 * 144 + d0 * 32); }
#define ATT_QK(g) do { _Pragma("unroll") for (int d0 = 0; d0 < 4; ++d0) { \
            p[g][0] = __builtin_amdgcn_mfma_f32_32x32x16_bf16(kf[0][d0], qf[g][d0], d0 == 0 ? z : p[g][0], 0, 0, 0); \
            p[g][1] = __builtin_amdgcn_mfma_f32_32x32x16_bf16(kf[1][d0], qf[g][d0], d0 == 0 ? z : p[g][1], 0, 0, 0); } } while (0)
#define MX3(a, b, c) fmaxf(fmaxf((a), (b)), (c))
#define ATT_MAX(g) do { float mx = MX3(p[g][0][0], p[g][1][0], p[g][0][1]), mx2 = MX3(p[g][1][1], p[g][0][2], p[g][1][2]); \
            _Pragma("unroll") for (int i = 3; i < 15; i += 2) { mx = MX3(mx, p[g][0][i], p[g][1][i]); mx2 = MX3(mx2, p[g][0][i + 1], p[g][1][i + 1]); } \
            mx = MX3(mx, p[g][0][15], p[g][1][15]); mx = fmaxf(mx, mx2); \
            mx = fmaxf(mx, __shfl_xor(mx, 32)); \
            if (__builtin_expect(__any(mx > m[g] + 16.0f), 0)) {      \
                const float dl = fmaxf(mx - m[g], 0.f); m[g] += dl; const float alpha = __builtin_amdgcn_exp2f(-dl); lsum[g] *= alpha; anym = true; \
                if (hi == 0) wsf[g * 32 + r] = alpha; \
                _Pragma("unroll") for (int i = 0; i < 16; ++i) { const float f = wsf[g * 32 + crow(i, hi)]; o[g][0][i] *= f; o[g][1][i] *= f; } } \
            if (__builtin_expect(anym, 0)) { const float mg = m[g];         \
                _Pragma("unroll") for (int i = 0; i < 16; ++i) { p[g][0][i] -= mg; p[g][1][i] -= mg; } } } while (0)
#define ATT_EXP(g) do { float ps = 0.f; \
            _Pragma("unroll") for (int i = 0; i < 16; ++i) { p[g][0][i] = __builtin_amdgcn_exp2f(p[g][0][i]); p[g][1][i] = __builtin_amdgcn_exp2f(p[g][1][i]); ps += p[g][0][i] + p[g][1][i]; } \
            lsum[g] += ps; \
            _Pragma("unroll") for (int kbk = 0; kbk < 2; ++kbk) _Pragma("unroll") for (int s = 0; s < 2; ++s) \
                pa[g][kbk][s] = (u32x4){cvtpk(p[g][kbk][8 * s], p[g][kbk][8 * s + 1]), cvtpk(p[g][kbk][8 * s + 2], p[g][kbk][8 * s + 3]), cvtpk(p[g][kbk][8 * s + 4], p[g][kbk][8 * s + 5]), cvtpk(p[g][kbk][8 * s + 6], p[g][kbk][8 * s + 7])}; } while (0)
#define ATT_PV(g) do { _Pragma("unroll") for (int kbk = 0; kbk < 2; ++kbk) _Pragma("unroll") for (int s = 0; s < 2; ++s) _Pragma("unroll") for (int db = 0; db < 2; ++db) \
            o[g][db] = __builtin_amdgcn_mfma_f32_32x32x16_bf16(__builtin_bit_cast(bf16x8, pa[g][kbk][s]), vf[kbk][s][db], o[g][db], 0, 0, 0); } while (0)
#define ATT_MIX(nv) do { _Pragma("unroll") for (int q_ = 0; q_ < 8; ++q_) { __builtin_amdgcn_sched_group_barrier(0x008, 1, 0); __builtin_amdgcn_sched_group_barrier(0x400, 4, 0); __builtin_amdgcn_sched_group_barrier(0x002, nv, 0); } } while (0)
        ATT_QK(0); ATT_MAX(0);
        asm volatile("" : "+v"(kf[0][0]), "+v"(kf[1][0]));
        ATT_QK(1); ATT_EXP(0); ATT_MIX(6);
        asm volatile("" : "+v"(pa[0][0][0]), "+v"(pa[0][0][1]), "+v"(pa[0][1][0]), "+v"(pa[0][1][1]), "+v"(lsum[0]));
        ATT_MAX(1);
        bf16x8 vf[2][2][2];
#pragma unroll
        for (int kbk = 0; kbk < 2; ++kbk)
#pragma unroll
            for (int s = 0; s < 2; ++s)
#pragma unroll
                for (int db = 0; db < 2; ++db) {
                    const s16x4 lo = *(const LAS s16x4*)(vb + db * 32 * 144 + (kbk * 32 + s * 16) * 2), hh = *(const LAS s16x4*)(vb + db * 32 * 144 + (kbk * 32 + s * 16 + 8) * 2);
                    vf[kbk][s][db] = (bf16x8){lo[0], lo[1], lo[2], lo[3], hh[0], hh[1], hh[2], hh[3]}; }
        ATT_PV(0); ATT_EXP(1); ATT_MIX(6);
        asm volatile("" : "+v"(pa[1][0][0]), "+v"(pa[1][0][1]), "+v"(pa[1][1][0]), "+v"(pa[1][1][1]), "+v"(lsum[1]));
        ATT_PV(1);
#undef ATT_QK
#undef ATT_MAX
#undef MX3
#undef ATT_EXP
#undef ATT_PV
#undef ATT_MIX
        if (more) { *(LAS u32x4*)(Ks + (cur ^ 1) * 9216 + srow * 144 + sch * 16) = kreg; *(LAS u32x4*)(Vs + (cur ^ 1) * 9216 + srow * 144 + sch * 16) = vreg; }
        __syncthreads();
    }
    const bool active = (w * 64 < nrows);
#pragma unroll
    for (int g = 0; g < 2; ++g) {
        float l = lsum[g]; l += __shfl_xor(l, 32);
        if (hi == 0) wsf[g * 32 + r] = 1.f / l;
        if (active) {
#pragma unroll
            for (int i = 0; i < 16; ++i) { const int q = crow(i, hi); const float f = wsf[g * 32 + q]; bf16* orow = Op + (size_t)(q0 + w * 64 + g * 32 + q) * DM;
                orow[r] = (bf16)f2bf(o[g][0][i] * f); orow[32 + r] = (bf16)f2bf(o[g][1][i] * f); }
        }
    }
    __syncthreads();
}

DI f32x2v cmul(f32x2v a, f32x2v b) { return (f32x2v){a.x * b.x - a.y * b.y, a.x * b.y + a.y * b.x}; }
DI int swz(int i) { return i ^ (((i >> 6) & 7) << 2); }
DI f32x2v cmulc(f32x2v a, f32x2v b) { return (f32x2v){a.x * b.x + a.y * b.y, a.y * b.x - a.x * b.y}; }
DI void bfly4f(f32x2v& a0, f32x2v& a1, f32x2v& a2, f32x2v& a3) {
    const f32x2v t0 = a0 + a2, t1 = a0 - a2, t2 = a1 + a3, d = a1 - a3; const f32x2v t3 = (f32x2v){d.y, -d.x};
    a0 = t0 + t2; a1 = t1 + t3; a2 = t0 - t2; a3 = t1 - t3;
}
DI void bfly4i(f32x2v& a0, f32x2v& a1, f32x2v& a2, f32x2v& a3) {
    const f32x2v s0 = a0 + a2, s1 = a0 - a2, s2 = a1 + a3, d = a1 - a3; const f32x2v s3 = (f32x2v){-d.y, d.x};
    a0 = s0 + s2; a1 = s1 + s3; a2 = s0 - s2; a3 = s1 - s3;
}
template <int T, bool INV> DI void fft_pass16(LAS f32x2v* buf, int tid) {
    asm volatile("" : "+v"(tid));
    constexpr float C1 = 0.9238795325112867f, S1 = 0.3826834323650898f, C2 = 0.7071067811865476f;
#pragma unroll 1
    for (int it = 0; it < 2; ++it) {
        const int j = tid + 512 * it, pos = j & (T - 1), base = ((j - pos) << 4) + pos;
        f32x2v e[16];
#pragma unroll
        for (int m = 0; m < 16; ++m) e[m] = buf[swz(base + m * T)];
        const float fr = (float)pos / (float)(16 * T);
        const f32x2v wp = (f32x2v){__builtin_amdgcn_cosf(fr), -__builtin_amdgcn_sinf(fr)};
        const f32x2v wp2 = cmul(wp, wp), wp4 = cmul(wp2, wp2);
        const f32x2v wp8 = cmul(wp4, wp4), wp12 = cmul(wp8, wp4);
        if (!INV) {
#pragma unroll
            for (int m = 0; m < 4; ++m) {
                const f32x2v c16 = (m == 0) ? (f32x2v){1.f, 0.f} : (m == 1) ? (f32x2v){C1, -S1} : (m == 2) ? (f32x2v){C2, -C2} : (f32x2v){S1, -C1};
                const f32x2v w1 = cmul(wp, c16), w2 = cmul(w1, w1), w3 = cmul(w2, w1);
                bfly4f(e[m], e[m + 4], e[m + 8], e[m + 12]);
                e[m + 4] = cmul(e[m + 4], w1); e[m + 8] = cmul(e[m + 8], w2); e[m + 12] = cmul(e[m + 12], w3);
            }
#pragma unroll
            for (int q = 0; q < 4; ++q) {
                bfly4f(e[4 * q], e[4 * q + 1], e[4 * q + 2], e[4 * q + 3]);
                e[4 * q + 1] = cmul(e[4 * q + 1], wp4); e[4 * q + 2] = cmul(e[4 * q + 2], wp8); e[4 * q + 3] = cmul(e[4 * q + 3], wp12);
            }
        } else {
#pragma unroll
            for (int q = 0; q < 4; ++q) {
                e[4 * q + 1] = cmulc(e[4 * q + 1], wp4); e[4 * q + 2] = cmulc(e[4 * q + 2], wp8); e[4 * q + 3] = cmulc(e[4 * q + 3], wp12);
                bfly4i(e[4 * q], e[4 * q + 1], e[4 * q + 2], e[4 * q + 3]);
            }
#pragma unroll
            for (int m = 0; m < 4; ++m) {
                const f32x2v c16 = (m == 0) ? (f32x2v){1.f, 0.f} : (m == 1) ? (f32x2v){C1, -S1} : (m == 2) ? (f32x2v){C2, -C2} : (f32x2v){S1, -C1};
                const f32x2v w1 = cmul(wp, c16), w2 = cmul(w1, w1), w3 = cmul(w2, w1);
                e[m + 4] = cmulc(e[m + 4], w1); e[m + 8] = cmulc(e[m + 8], w2); e[m + 12] = cmulc(e[m + 12], w3);
                bfly4i(e[m], e[m + 4], e[m + 8], e[m + 12]);
            }
        }
#pragma unroll
        for (int m = 0; m < 16; ++m) buf[swz(base + m * T)] = e[m];
    }
    __syncthreads();
}
template <bool INV> DI void fft_pass4_s1(LAS f32x2v* buf, int tid) {
    asm volatile("" : "+v"(tid));
#pragma unroll 2
    for (int it = 0; it < 8; ++it) {
        const int b = swz((tid + 512 * it) << 2);
        f32x2v a0 = buf[b], a1 = buf[b + 1], a2 = buf[b + 2], a3 = buf[b + 3];
        if (!INV) bfly4f(a0, a1, a2, a3); else bfly4i(a0, a1, a2, a3);
        buf[b] = a0; buf[b + 1] = a1; buf[b + 2] = a2; buf[b + 3] = a3;
    }
    __syncthreads();
}
DI void fft_fwd(LAS f32x2v* buf, int tid) { fft_pass16<1024, false>(buf, tid); fft_pass16<64, false>(buf, tid); fft_pass16<4, false>(buf, tid); fft_pass4_s1<false>(buf, tid); }
DI void fft_inv(LAS f32x2v* buf, int tid) { fft_pass4_s1<true>(buf, tid); fft_pass16<4, true>(buf, tid); fft_pass16<64, true>(buf, tid); fft_pass16<1024, true>(buf, tid); }

DI void hyena_unit(Ctx& C, int l, int c, f32x2v* park, int dry = 0) {
    LAS f32x2v* buf = (LAS f32x2v*)C.lds; LAS float* red = (LAS float*)(C.lds + 131072);
    int tid = C.tid; asm volatile("" : "+v"(tid));
    bf16* ZT = WSP(bf16, WS_ZT); const float* FT = WSP(float, WS_FT);
    bf16* u0 = ZT + (size_t)(0 * 768 + 512 + c) * SEQ; bf16* u1 = ZT + (size_t)(1 * 768 + 512 + c) * SEQ;
    f32x2v* spec = park + SEQ;
#pragma unroll 1
    for (int o = 0; o < 2; ++o) {
        const float* hf = FT + (size_t)((o * 2 + 0) * 256 + c) * SEQ; const float* hb = FT + (size_t)((o * 2 + 1) * 256 + c) * SEQ;
        const bf16* g0 = ZT + (size_t)(0 * 768 + o * 256 + c) * SEQ; const bf16* g1 = ZT + (size_t)(1 * 768 + o * 256 + c) * SEQ;
        const float skip = INP(31)[(l * 2 + o) * 256 + c];
        if (o == 0) {
#pragma unroll 32
            for (int n = tid; n < SEQ; n += NTHR) buf[swz(n)] = (f32x2v){bf2f(u0[n]), bf2f(u1[n])};
        }
        __syncthreads(); fft_fwd(buf, tid);
        float sabs = 0.f;
#pragma unroll 32
        for (int n = tid; n < SEQ; n += NTHR) { const int ns = swz(n); spec[n] = buf[ns]; const float a = hf[n], b = n ? hb[SEQ - n] : 0.f; sabs += fabsf(a) + fabsf(b); buf[ns] = (f32x2v){a + b, 0.f}; }
        __syncthreads(); fft_fwd(buf, tid);
#pragma unroll 32
        for (int n = tid; n < SEQ; n += NTHR) { const int ns = swz(n); buf[ns] = cmul(buf[ns], spec[n]); }
        __syncthreads(); fft_inv(buf, tid);
#pragma unroll 32
        for (int n = tid; n < SEQ; n += NTHR) { const int ns = swz(n); park[n] = buf[ns]; const float fr = (float)n * (1.0f / 32768.0f); const f32x2v wv = (f32x2v){__builtin_amdgcn_cosf(fr), -__builtin_amdgcn_sinf(fr)};
            buf[ns] = cmul((f32x2v){bf2f(u0[n]), bf2f(u1[n])}, wv); }
        __syncthreads(); fft_fwd(buf, tid);
#pragma unroll 32
        for (int n = tid; n < SEQ; n += NTHR) { const int ns = swz(n); spec[n] = buf[ns]; const float a = hf[n], b = n ? hb[SEQ - n] : 0.f; const float fr = (float)n * (1.0f / 32768.0f); const float d = a - b;
            buf[ns] = (f32x2v){d * __builtin_amdgcn_cosf(fr), -d * __builtin_amdgcn_sinf(fr)}; }
        __syncthreads(); fft_fwd(buf, tid);
#pragma unroll 32
        for (int n = tid; n < SEQ; n += NTHR) { const int ns = swz(n); buf[ns] = cmul(buf[ns], spec[n]); }
        __syncthreads(); fft_inv(buf, tid);
        sabs = wave_sum(sabs); if (C.lane == 0) red[C.wave] = sabs;
        __syncthreads();
        float tot = 0.f;
#pragma unroll
        for (int w = 0; w < 8; ++w) tot += red[w];
        const float nrm = 1.0f / (32768.0f * tot);
#pragma unroll 16
        for (int n = tid; n < SEQ; n += NTHR) { const float fr = (float)n * (1.0f / 32768.0f); const f32x2v wc = (f32x2v){__builtin_amdgcn_cosf(fr), __builtin_amdgcn_sinf(fr)};
            const f32x2v cv = (park[n] + cmul(buf[swz(n)], wc)) * nrm; const float x0 = bf2f(u0[n]), x1 = bf2f(u1[n]);
            const float y0 = bf2f(g0[n]) * (cv.x + skip * x0), y1 = bf2f(g1[n]) * (cv.y + skip * x1);
            if (dry) { if (y0 == 1.2345e30f) u0[n] = 0; }
            else if (o == 0) { const unsigned b0 = f2bf(y0), b1 = f2bf(y1); u0[n] = (bf16)b0; u1[n] = (bf16)b1; buf[swz(n)] = (f32x2v){bf2f(b0), bf2f(b1)}; }
            else { WSP(bf16, WS_YDT)[(size_t)(0 * 256 + c) * SEQ + n] = (bf16)f2bf(y0); WSP(bf16, WS_YDT)[(size_t)(1 * 256 + c) * SEQ + n] = (bf16)f2bf(y1); } }
        __syncthreads();
    }
}

DI void hyena_ctx_unit(Ctx& C, int l, int c) {
    LAS float* hh = (LAS float*)C.lds; LAS float* us = hh + 512; LAS float* red = us + 512;
    int tid = C.tid; asm volatile("" : "+v"(tid)); const int b = tid >> 8, t = tid & 255; const bf16* ZTC = WSP(bf16, WS_ZTC); const float* FTC = WSP(float, WS_FTC);
    float u = bf2f(ZTC[(size_t)(b * 768 + 512 + c) * CTXL + t]);
    for (int o = 0; o < 2; ++o) {
        float av = 0.f;
        if (tid < 511) { const int i = tid - 255; const float v = (i >= 0) ? FTC[(size_t)((o * 2 + 0) * 256 + c) * CTXL + i] : FTC[(size_t)((o * 2 + 1) * 256 + c) * CTXL - i]; hh[tid] = v; av = fabsf(v); }
        us[b * 256 + t] = u;
        av = wave_sum(av); if ((tid & 63) == 0) red[tid >> 6] = av;
        __syncthreads();
        float tot = 0.f;
#pragma unroll
        for (int w = 0; w < 8; ++w) tot += red[w];
        float acc = 0.f;
#pragma unroll 16
        for (int s2 = 0; s2 < 256; ++s2) acc += hh[255 + t - s2] * us[b * 256 + s2];
        const float gate = bf2f(ZTC[(size_t)(b * 768 + o * 256 + c) * CTXL + t]); const float skip = INP(31)[(l * 2 + o) * 256 + c];
        u = gate * (acc / tot + skip * u);
        __syncthreads();
    }
    WSP(bf16, WS_YDTC)[(size_t)(b * 256 + c) * CTXL + t] = (bf16)f2bf(u);
}

DI void ydt_transpose(Ctx& C, const Tile& T) {
    LAS bf16* ts = (LAS bf16*)C.lds;
    int tid = C.tid; asm volatile("" : "+v"(tid));
#pragma unroll
    for (int i = 0; i < 4; ++i) { const int task = tid + 512 * i, ch = task >> 3, chunk = task & 7;
        const bf16* src = T.lat ? WSP(bf16, WS_YDT) + (size_t)(T.b * 256 + ch) * SEQ + T.p0 + chunk * 8 : WSP(bf16, WS_YDTC) + (size_t)(T.b * 256 + ch) * CTXL + T.p0 + chunk * 8;
        *(LAS u32x4*)(ts + ch * 72 + chunk * 8) = *(const u32x4*)src; }
    __syncthreads();
    const int tok = tid >> 3, cg8 = tid & 7;
#pragma unroll
    for (int q = 0; q < 4; ++q) { unsigned short e[8];
#pragma unroll
        for (int j = 0; j < 8; ++j) e[j] = ts[(cg8 * 32 + q * 8 + j) * 72 + tok];
        u32x4 w; w.x = e[0] | ((unsigned)e[1] << 16); w.y = e[2] | ((unsigned)e[3] << 16); w.z = e[4] | ((unsigned)e[5] << 16); w.w = e[6] | ((unsigned)e[7] << 16);
        *(u32x4*)(WSP(bf16, WS_MIX) + (size_t)(T.m0 + tok) * DM + 768 + cg8 * 32 + q * 8) = w; }
    __syncthreads();
}
#define XB_TMO      128
#define XB_XCNT(j)  (256  + 64 * (j))
#define XB_XSUB(j)  (1280 + 64 * (j))
#define XB_XGEN(j)  (2304 + 64 * (j))
#define XB_TOP      3328
#define XB_TOPGEN   3392
#define XCD_BAR_WORDS 3456
#define XB_SPIN_CAP (1u << 18)

__device__ __forceinline__ unsigned xb_ld(unsigned* p)              { return __hip_atomic_load(p, __ATOMIC_RELAXED, __HIP_MEMORY_SCOPE_AGENT); }
__device__ __forceinline__ unsigned xb_add(unsigned* p, unsigned v) { return __hip_atomic_fetch_add(p, v, __ATOMIC_RELAXED, __HIP_MEMORY_SCOPE_AGENT); }
__device__ __forceinline__ unsigned xb_xcc_id() { return (unsigned)__builtin_amdgcn_s_getreg((3 << 11) | 20) & 0xFu; }
#define XB_SPIN(cond, bar) do { unsigned _sp = 0; while (cond) { __builtin_amdgcn_s_sleep(1); \
    if ((++_sp & 255u) == 0u) { if (xb_ld(&(bar)[XB_TMO])) break; if (_sp > XB_SPIN_CAP) { atomicAdd(&(bar)[XB_TMO], 1u); break; } } } } while (0)

struct XcdBarrier {
    unsigned* bar; unsigned x;
    volatile LAS unsigned* st;
};

__device__ __forceinline__ XcdBarrier xcd_barrier_post(unsigned* bar, volatile LAS unsigned* st) {
    XcdBarrier b; b.bar = bar; b.x = xb_xcc_id(); b.st = st;
    if (threadIdx.x == 0) (void)xb_add(&bar[XB_XCNT(b.x)], 1u);
    return b;
}
__device__ __forceinline__ void xcd_barrier_complete(unsigned* bar, unsigned x, unsigned& nloc, unsigned& nx) {
    const unsigned G = gridDim.x * gridDim.y * gridDim.z;
    unsigned sum, cnt, mine, sp = 0u;
    for (;;) {
        sum = 0u; cnt = 0u; mine = 0u;
#pragma unroll
        for (unsigned j = 0; j < 16; ++j) { const unsigned c = xb_ld(&bar[XB_XCNT(j)]); sum += c; cnt += (c > 0u) ? 1u : 0u; mine = (j == x) ? c : mine; }
        if (sum == G) break;
        __builtin_amdgcn_s_sleep(1);
        if ((++sp & 255u) == 0u) { if (xb_ld(&bar[XB_TMO])) break; if (sp > XB_SPIN_CAP) { atomicAdd(&bar[XB_TMO], 1u); break; } }
    }
    nloc = mine > 0u ? mine : 1u; nx = cnt > 0u ? cnt : 1u;
}

__device__ __forceinline__ void xcd_barrier(const XcdBarrier& b) {
    asm volatile("s_waitcnt vmcnt(0)" ::: "memory");
    __syncthreads();
    if (threadIdx.x == 0) {
        unsigned* bar = b.bar;
        __builtin_amdgcn_s_waitcnt(0);
        unsigned nloc = b.st[0], nx = b.st[1];
        if (nloc == 0u) { xcd_barrier_complete(bar, b.x, nloc, nx); b.st[0] = nloc; b.st[1] = nx; }
        const unsigned old = xb_add(&bar[XB_XSUB(b.x)], 1u);
        const unsigned gen = old / nloc;
        if (old + 1u == (gen + 1u) * nloc) {
            __builtin_amdgcn_fence(__ATOMIC_RELEASE, "agent");
            asm volatile("s_waitcnt vmcnt(0)" ::: "memory");
            const unsigned og = xb_add(&bar[XB_TOP], 1u);
            const unsigned tg = og / nx;
            if (og + 1u == (tg + 1u) * nx) xb_add(&bar[XB_TOPGEN], 1u);
            else XB_SPIN(xb_ld(&bar[XB_TOPGEN]) == tg, bar);
            __builtin_amdgcn_fence(__ATOMIC_ACQUIRE, "agent");
            xb_add(&bar[XB_XGEN(b.x)], 1u);
            asm volatile("s_waitcnt vmcnt(0)" ::: "memory");
        } else {
            XB_SPIN(xb_ld(&bar[XB_XGEN(b.x)]) == gen, bar);
            __builtin_amdgcn_fence(__ATOMIC_ACQUIRE, "agent");
            asm volatile("s_waitcnt vmcnt(0)" ::: "memory");
        }
    }
    __syncthreads();
}
DI void rows_phase(Ctx& C, int l, int which) {
    const int gw = C.bid * NWV + C.wave, NGW = C.G * NWV; const float* MOD = WSP(float, WS_MOD);
#ifndef NO_ROWS
    if (which == 1) {
        LAS float* P1 = (LAS float*)C.lds;
        f32x4 pr[5];
#pragma unroll
        for (int i = 0; i < 5; ++i) { const int e0 = C.tid + NTHR * i, e = e0 < 9 * 256 ? e0 : 9 * 256 - 1; const int cond = e / 768, v = (e / 256) % 3, c4 = (e & 255) * 4;
            const float* src = (v == 0) ? INP(6) : MOD + (size_t)cond * 6144 + (v == 1 ? 0 : 1024); pr[i] = *(const f32x4*)(src + c4); }
#pragma unroll
        for (int i = 0; i < 5; ++i) { const int e = C.tid + NTHR * i; if (e < 9 * 256) *(LAS f32x4*)(P1 + (e / 256) * 1024 + (e & 255) * 4) = pr[i]; }
        __syncthreads();
        for (int m0 = gw * 4; m0 < MTOT; m0 += NGW * 4) { const int cond = row_cond(m0); const bool lat = m0 < MLAT; const LAS float* pv = P1 + cond * 3 * 1024;
            const float* xr[4]; bf16* xn[4];
#pragma unroll
            for (int q = 0; q < 4; ++q) { const int m = m0 + q; xr[q] = lat ? INP(0) + (size_t)m * DM : INP(2) + (size_t)(m - MLAT) * DM; xn[q] = WSP(bf16, WS_XN) + (size_t)m * DM; }
            row_norm_mod_n<4>(xr, pv, pv + 1024, pv + 2048, xn, C.lane); }
        __syncthreads();
        return;
    }
    constexpr int NR = 4;
    LAS float* PV = (LAS float*)C.lds;
    {
        const bool nxt = (l + 1 < DEPTH); const int ln = (which == 2) ? l : (nxt ? l + 1 : l);
        f32x4 pvr[8];
#pragma unroll
        for (int i = 0; i < 8; ++i) { const int e0 = C.tid + NTHR * i, e = e0 < 3 * 5 * 256 ? e0 : 3 * 5 * 256 - 1; const int cond = e / 1280, v = (e / 256) % 5, c4 = (e & 255) * 4;
            const float* modl = MOD + (size_t)(l * 3 + cond) * 6144; const float* modn = MOD + (size_t)(ln * 3 + cond) * 6144; const float* src;
            if (which == 2) src = (v == 0) ? INP(7) + l * DM : (v == 1) ? modl + 2048 : (v == 2) ? INP(8) + l * DM : (v == 3) ? modl + 3072 : modl + 4096;
            else src = (v == 0) ? INP(9) + l * DM : (v == 1) ? modl + 5120 : (v == 2) ? INP(6) + ln * DM : (v == 3) ? modn : modn + 1024;
            pvr[i] = *(const f32x4*)(src + c4); }
#pragma unroll
        for (int i = 0; i < 8; ++i) { const int e = C.tid + NTHR * i; if (e < 3 * 5 * 256) *(LAS f32x4*)(PV + (e / 256) * 1024 + (e & 255) * 4) = pvr[i]; }
        __syncthreads();
    }
    const int Mr = (l == DEPTH - 1) ? MLAT : MTOT;
    for (int m0 = gw * NR; m0 < Mr; m0 += NGW * NR) {
        const int cond = row_cond(m0); const bool lat = m0 < MLAT; const LAS float* pv = PV + cond * 5 * 1024;
        const float* xi[NR]; const bf16* y[NR]; float* xo[NR]; bf16* xn[NR];
#pragma unroll
        for (int q = 0; q < NR; ++q) { const int m = m0 + q;
            float* xcur = lat ? C.out + (size_t)m * DM : WSP(float, WS_CX) + (size_t)(m - MLAT) * DM;
            const float* xorig = lat ? INP(0) + (size_t)m * DM : INP(2) + (size_t)(m - MLAT) * DM;
            xi[q] = (which == 2 && l == 0) ? xorig : xcur; xo[q] = xcur; xn[q] = WSP(bf16, WS_XN) + (size_t)m * DM;
            y[q] = (which == 2 ? WSP(bf16, WS_PX) : WSP(bf16, WS_MIX)) + (size_t)m * DM; }
        row_update<NR>(xi, y, pv, pv + 1024, xo, pv + 2048, pv + 3072, pv + 4096, xn, which == 2 || (l + 1 < DEPTH), C.lane);
    }
    __syncthreads();
#endif
}
DI void ft_phase(Ctx& C, int l) {
    for (int rep_ = 0; rep_ < (PROBE_FT ? 2 : 1); ++rep_)
    for (int it = C.bid; it < 256 + (l == 0 ? 4 : 0); it += C.G) {
        if (it < 256) ft_item(C, WSP(float, WS_H2) + (size_t)l * SEQ * 64, WSP(float, WS_W3T) + (size_t)l * 65536, WSP(float, WS_FT), SEQ, it * 64);
        else ft_item(C, WSP(float, WS_H2C), WSP(float, WS_W3T), WSP(float, WS_FTC), CTXL, (it - 256) * 64);
    }
}
template <int ACT> DI void gemm_run(Ctx& C, const bf16* A, const bf16* Bt, int M, int N, int K, bf16* O) {
    pg8::Gemm g{A, Bt, M, N, K}; pg8::StaticOrder S; S.init(M, N, C.G, C.bid);
    pg8::EpiBf16<ACT> E{O, N};
#ifndef NO_GEMM
    for (int rep_ = 0; rep_ < (PROBE_GEMM ? 2 : 1); ++rep_)
    pg8::gemm_phase<pg8::EpiBf16<ACT>, pg8::StaticOrder, true, true>((PG8_LAS unsigned char*)C.lds, g, S, E);
#endif
    __syncthreads();
}

#define GSYNC() do { xcd_barrier(bar); if (PROBE_SYNC) xcd_barrier(bar); } while (0)
#define RELAUNDER() do { int t_ = threadIdx.x; asm volatile("" : "+v"(t_)); C.tid = t_; C.lane = t_ & 63; } while (0)
__global__ void __launch_bounds__(NTHR, 2) fwd_megakernel(Args args) {
    extern __shared__ __attribute__((aligned(16))) unsigned char lds_raw[];
    cg::grid_group grid = cg::this_grid();
    Ctx C; C.in = args.in; C.out = args.out; C.ws = args.ws; C.lds = (LAS unsigned char*)lds_raw;
    C.tid = threadIdx.x; C.lane = C.tid & 63; C.wave = __builtin_amdgcn_readfirstlane(C.tid >> 6); C.G = gridDim.x; C.bid = blockIdx.x;
    volatile LAS unsigned* bst = (volatile LAS unsigned*)(C.lds + 131072 + 256);
    if (threadIdx.x < 2) bst[threadIdx.x] = 0u;
    __syncthreads();
    XcdBarrier bar = xcd_barrier_post((unsigned*)args.ws, bst);

#ifndef NO_P0
    phase0(C);
    if (PROBE_P0) { __syncthreads(); RELAUNDER(); phase0(C); }
#endif
    grid.sync(); RELAUNDER();
    rows_phase(C, 0, 1); RELAUNDER();
#ifndef NO_FT
    ft_phase(C, 0);
#endif
    GSYNC(); RELAUNDER();
    for (int l = 0; l < DEPTH; ++l) {
        gemm_run<0>(C, WSP(bf16, WS_XN), WSP(bf16, WS_WIN) + (size_t)l * INC * DM, MTOT, INC, DM, WSP(bf16, WS_PX));
        GSYNC(); RELAUNDER();
#ifndef NO_PREP
        for (int rep_ = 0; rep_ < (PROBE_PREP ? 2 : 1); ++rep_)
        for (int it = C.bid; it < NTILE64 * 9; it += C.G) {
            const int tt = it / 9, sub = it % 9; const Tile T = tile_of(tt);
            if (sub == 0) prep_qkv(C, l, T);
            else if (sub <= 3) prep_hyena(C, l, T, sub - 1);
            else if (sub == 4) prep_pool(C, l, T);
#ifndef NO_LRU
            else lru_item<1>(C, l, T, sub - 5);
#endif
        }
#endif
        GSYNC(); RELAUNDER();
        {
            lru_carry(C);
            const int nat = 256 + (l == 0 ? 8 : 0);
#ifndef NO_ATT
            for (int rep_ = 0; rep_ < (PROBE_ATT ? 2 : 1); ++rep_)
            for (int u = C.bid; u < nat; u += C.G) {
                if (u < 256) { const int b = u >> 7, h = (u >> 5) & 3, qt = u & 31, kvh = h >> 1;
                    attn_unit(C, WSP(bf16, WS_Q) + (size_t)(b * 4 + h) * SEQ * 64, WSP(bf16, WS_K) + (size_t)(b * 2 + kvh) * SKV * 64, WSP(bf16, WS_VT) + (size_t)(b * 2 + kvh) * 64 * SKV, SKV / 64,
                              WSP(bf16, WS_MIX) + (size_t)(b * SEQ) * DM + 256 + h * 64, qt * 512, 512); }
                else { const int uc = u - 256, b = uc >> 2, h = uc & 3, kvh = h >> 1;
                    attn_unit(C, WSP(bf16, WS_QC) + (size_t)(b * 4 + h) * CTXL * 64, WSP(bf16, WS_K) + (size_t)(b * 2 + kvh) * SKV * 64, WSP(bf16, WS_VT) + (size_t)(b * 2 + kvh) * 64 * SKV, CTXL / 64,
                              WSP(bf16, WS_MIX) + (size_t)(MLAT + b * CTXL) * DM + 256 + h * 64, 0, 256); }
            }
#endif
            RELAUNDER();
#ifndef NO_HY
#if PROBE_HY
            for (int c = C.bid; c < 256; c += C.G) hyena_unit(C, l, c, (f32x2v*)(C.ws + WS_XN) + (size_t)C.bid * 2 * SEQ, 1);
            RELAUNDER();
#endif
            for (int c = C.bid; c < 256; c += C.G) hyena_unit(C, l, c, (f32x2v*)(C.ws + WS_XN) + (size_t)C.bid * 2 * SEQ);
#endif
            RELAUNDER();
#ifndef NO_HYC
            if (l == 0) for (int c = C.bid; c < 256; c += C.G) hyena_ctx_unit(C, l, c);
#endif
        }
        GSYNC(); RELAUNDER();
#ifndef NO_TR
        for (int rep_ = 0; rep_ < (PROBE_TR ? 2 : 1); ++rep_)
        for (int tt = C.bid; tt < NTILE64; tt += C.G) ydt_transpose(C, tile_of(tt));
#endif
        RELAUNDER();
#ifndef NO_LRU
        for (int rep_ = 0; rep_ < (PROBE_TR ? 2 : 1); ++rep_)
        for (int it = C.bid; it < NTILE64 * 4; it += C.G) lru_item<2>(C, l, tile_of(it >> 2), it & 3);
#endif
        GSYNC(); RELAUNDER();
        const int Mg = (l == DEPTH - 1) ? MLAT : MTOT;
        gemm_run<0>(C, WSP(bf16, WS_MIX), WSP(bf16, WS_WOUT) + (size_t)l * DM * DM, Mg, DM, DM, WSP(bf16, WS_PX));
        GSYNC(); RELAUNDER();
        rows_phase(C, l, 2);
        if (PROBE_ROWS && l == 0) { RELAUNDER(); rows_phase(C, l, 2); }
        GSYNC(); RELAUNDER();
        gemm_run<2>(C, WSP(bf16, WS_XN), WSP(bf16, WS_W1) + (size_t)l * DFF * DM, Mg, DFF, DM, WSP(bf16, WS_PX));
        GSYNC(); RELAUNDER();
        gemm_run<0>(C, WSP(bf16, WS_PX), WSP(bf16, WS_W2) + (size_t)l * DM * DFF, Mg, DM, DFF, WSP(bf16, WS_MIX));
        GSYNC(); RELAUNDER();
        rows_phase(C, l, 3); RELAUNDER();
        if (l + 1 < DEPTH) {
#ifndef NO_FT
            ft_phase(C, l + 1);
#endif
            GSYNC(); RELAUNDER(); }
    }
}

extern "C" void kernel_launch(void* const* d_in, const int* in_sizes, int n_in, void* d_out, int out_size, void* d_ws, size_t ws_size, hipStream_t stream) {
    static int grid_blocks = 0;
    if (grid_blocks == 0) {
        if (n_in != 34 || ws_size < WS_END) { fprintf(stderr, "kernel_launch: unexpected n_in %d / ws %zu\n", n_in, ws_size); grid_blocks = -1; return; }
        int dev = 0, cus = 0, per_cu = 0;
        hipGetDevice(&dev); hipDeviceGetAttribute(&cus, hipDeviceAttributeMultiprocessorCount, dev);
        if (hipFuncSetAttribute((const void*)fwd_megakernel, hipFuncAttributeMaxDynamicSharedMemorySize, LDS_BYTES) != hipSuccess) { fprintf(stderr, "kernel_launch: hipFuncSetAttribute failed\n"); }
        if (hipOccupancyMaxActiveBlocksPerMultiprocessor(&per_cu, (const void*)fwd_megakernel, NTHR, LDS_BYTES) != hipSuccess || per_cu < 1) per_cu = 1;
        (void)hipGetLastError();
        grid_blocks = cus * per_cu; if (grid_blocks > 256) grid_blocks = 256;
    }
    if (grid_blocks < 0) return;
    Args a{};
    for (int i = 0; i < 34; ++i) a.in[i] = (const float*)d_in[i];
    a.out = (float*)d_out; a.ws = (unsigned char*)d_ws;
    void* kargs[] = {&a};
    if (hipMemsetAsync(d_ws, 0, 65536, stream) != hipSuccess) { fprintf(stderr, "kernel_launch: memset failed\n"); return; }
    hipError_t e = hipLaunchCooperativeKernel((const void*)fwd_megakernel, dim3(grid_blocks), dim3(NTHR), kargs, LDS_BYTES, stream);
    if (e != hipSuccess) fprintf(stderr, "cooperative launch failed: %s (grid %d)\n", hipGetErrorString(e), grid_blocks);
}
```

```cpp
#include <hip/hip_runtime.h>
#include <hip/hip_cooperative_groups.h>
#include <cstdio>
#include <cstdint>
namespace cg = cooperative_groups;
#ifndef PROBE_ATT
#define PROBE_ATT 0
#endif
#ifndef PROBE_GEMM
#define PROBE_GEMM 0
#endif
#ifndef PROBE_PREP
#define PROBE_PREP 0
#endif
#ifndef PROBE_HY
#define PROBE_HY 0
#endif
#ifndef PROBE_SYNC
#define PROBE_SYNC 0
#endif
#ifndef PROBE_P0
#define PROBE_P0 0
#endif
#ifndef PROBE_FT
#define PROBE_FT 0
#endif
#ifndef PROBE_TR
#define PROBE_TR 0
#endif
#ifndef PROBE_ROWS
#define PROBE_ROWS 0
#endif
namespace pg8 {
#define PG8_LAS __attribute__((address_space(3)))
typedef unsigned short bf16_t;
typedef short bf16x8 __attribute__((ext_vector_type(8)));
typedef float f32x4 __attribute__((ext_vector_type(4)));
typedef unsigned u32x4 __attribute__((ext_vector_type(4)));
constexpr int BM = 256, BK = 64, HALF = 128, HTB = HALF * BK * 2  , STAGE_BYTES = 8 * HTB, NXCD = 8, WGM = 8;

__host__ __device__ __forceinline__ int lds_byte(int r, int c) { const int st = (r >> 4) * 2 + (c >> 5), rr = r & 15, cc = c & 31, ob = rr * 64 + cc * 2; return st * 1024 + (ob ^ (((ob >> 9) & 1) << 5)); }
__host__ __device__ __forceinline__ void stage_rc(int b, int& R, int& C) { const int st = b / 1024, sb = b % 1024, swz = sb ^ (((sb >> 9) & 1) << 5); R = (st >> 1) * 16 + swz / 64; C = (st & 1) * 32 + (swz % 64) / 2; }
__host__ __device__ __forceinline__ int perm32(int rho) { const int n = rho >> 4, i = rho & 15; return 8 * (i >> 2) + 4 * n + (i & 3); }

struct Unit { int pm, pn; };
struct Gemm { const bf16_t* A; const bf16_t* Bt; int M, N, K; };

struct StaticOrder {
    int nM, nN, nwg, G, c;
    __host__ __device__ void init(int M, int N, int G_, int c_) { nM = M / BM; nN = N / BM; nwg = nM * nN; G = G_; c = c_; }
    __host__ __device__ bool next(int i, Unit& u) const {
        const long L = (long)i * G + c; if (L >= nwg) return false;
        int wgid = (int)L; { const int q = nwg / NXCD, r = nwg % NXCD, xcd = wgid % NXCD, off = wgid / NXCD; wgid = (xcd < r ? xcd * (q + 1) : r * (q + 1) + (xcd - r) * q) + off; }
        const int nig = WGM * nN, gid = wgid / nig, fm = gid * WGM, gsz = (nM - fm) < WGM ? (nM - fm) : WGM;
        u.pm = fm + ((wgid % nig) % gsz); u.pn = (wgid % nig) / gsz; return true;
    }
    __device__ __forceinline__ void a_ready(const Unit&) const {}
    __device__ __forceinline__ void done(const Unit&) const {}
};
__device__ __forceinline__ unsigned cvt_pk_bf16(float lo, float hi) { unsigned r; asm volatile("v_cvt_pk_bf16_f32 %0, %1, %2" : "=v"(r) : "v"(lo), "v"(hi)); return r; }
typedef float f32x2 __attribute__((ext_vector_type(2)));template <int ACT  > struct EpiBf16 {
    static constexpr bool PERM = true, AFTER_DRAIN = false;
    bf16_t* O; int ldc;
    __device__ __forceinline__ void operator()(const f32x4 (&acc)[2][2][4][2], const Unit& u, int wr, int wc, int fr, int fq) const {
        const int row0 = u.pm * BM + wr * 64 + fr; const int col0 = u.pn * BM + wc * 32 + 8 * fq;
#pragma unroll
        for (int ai = 0; ai < 2; ++ai)
#pragma unroll
            for (int m = 0; m < 4; ++m) { bf16_t* rowp = O + (size_t)(row0 + ai * HALF + m * 16) * ldc + col0;
#pragma unroll
                for (int bj = 0; bj < 2; ++bj) { f32x4 v0 = acc[ai][bj][m][0], v1 = acc[ai][bj][m][1];
                    if (ACT == 2) {
#pragma unroll
                        for (int e = 0; e < 4; ++e) { float a = v0[e] > 0.f ? v0[e] : 0.f; v0[e] = a * a; float b = v1[e] > 0.f ? v1[e] : 0.f; v1[e] = b * b; } }
                    u32x4 w; w.x = cvt_pk_bf16(v0[0], v0[1]); w.y = cvt_pk_bf16(v0[2], v0[3]); w.z = cvt_pk_bf16(v1[0], v1[1]); w.w = cvt_pk_bf16(v1[2], v1[3]);
                    *(u32x4*)(rowp + bj * HALF) = w; } }
    }
};
template <class Epi, class Sched, bool ALIGN_EPI = false, bool SP2 = false>
__device__ __forceinline__ void gemm_phase(PG8_LAS unsigned char* lds, const Gemm g, const Sched& S, const Epi& E) {
    int tid_ = threadIdx.x; asm volatile("" : "+v"(tid_)); const int tid = tid_, wid = __builtin_amdgcn_readfirstlane(tid >> 6), lane = tid & 63, wr = wid >> 2, wc = wid & 3, fr = lane & 15, fq = lane >> 4;
    const int K = g.K, nt = K / BK;
    unsigned voffA[2], voffB[2];
#pragma unroll
    for (int i = 0; i < 2; ++i) { int R, C; stage_rc(tid * 16 + i * 8192, R, C); const int Rb = Epi::PERM ? ((R & ~31) + perm32(R & 31)) : R;
        voffA[i] = (unsigned)(R * K + C) * 2u; voffB[i] = (unsigned)(Rb * K + C) * 2u; }
    const size_t kstep = (size_t)(BK * 2);
    const size_t hstep = (size_t)HALF * K * 2;
    const size_t tstep = 2 * hstep;
    const unsigned ldsw = (unsigned)wid * 1024u;
    const int aoff = lds_byte(wr * 64 + fr, fq * 8), boff = lds_byte(wc * 32 + fr, fq * 8);
#define PG8_SA(b, h) (((b) * 2 + (h)) * HTB)
#define PG8_SB(b, h) ((4 + (b) * 2 + (h)) * HTB)
#define PG8_STAGE(bufoff, gbase, voff) do { _Pragma("unroll") for (int _i = 0; _i < 2; ++_i) \
        __builtin_amdgcn_global_load_lds((const unsigned*)((const char*)(gbase) + (voff)[_i]), (PG8_LAS unsigned*)(lds + (bufoff) + ldsw + _i * 8192), 16, 0, 0); } while (0)
#define PG8_LDA(dst, b, h) do { _Pragma("unroll") for (int m = 0; m < 4; ++m) _Pragma("unroll") for (int k = 0; k < 2; ++k) dst[m][k] = *(const PG8_LAS bf16x8*)(lds + PG8_SA(b, h) + aoff + m * 2048 + k * 1024); } while (0)
#define PG8_LDB(dst, b, h) do { _Pragma("unroll") for (int n = 0; n < 2; ++n) _Pragma("unroll") for (int k = 0; k < 2; ++k) dst[n][k] = *(const PG8_LAS bf16x8*)(lds + PG8_SB(b, h) + boff + n * 2048 + k * 1024); } while (0)
#define PG8_MMA(ai, bj, At, Bt) do { __builtin_amdgcn_s_setprio(1); _Pragma("unroll") for (int m = 0; m < 4; ++m) _Pragma("unroll") for (int n = 0; n < 2; ++n) _Pragma("unroll") for (int k = 0; k < 2; ++k) \
        acc[ai][bj][m][n] = __builtin_amdgcn_mfma_f32_16x16x32_bf16(Bt[n][k], At[m][k], acc[ai][bj][m][n], 0, 0, 0); __builtin_amdgcn_s_setprio(0); } while (0)
#define PG8_WAIT_V(n) asm volatile("s_waitcnt vmcnt(" #n ")" ::: "memory")
#define PG8_WAIT_L(n) asm volatile("s_waitcnt lgkmcnt(" #n ")" ::: "memory")
#define PG8_BAR __builtin_amdgcn_s_barrier()
#define PG8_SCHED __builtin_amdgcn_sched_barrier(0)
    Unit cur, nxt; int ui = 0;
    if (!S.next(0, cur)) return;
    f32x4 acc[2][2][4][2];
#pragma unroll
    for (int a = 0; a < 2; ++a)
#pragma unroll
        for (int b = 0; b < 2; ++b)
#pragma unroll
            for (int m = 0; m < 4; ++m)
#pragma unroll
                for (int n = 0; n < 2; ++n) acc[a][b][m][n] = (f32x4){0.f, 0.f, 0.f, 0.f};
    bf16x8 At[4][2], B0[2][2], B1[2][2];
    const char* cA = (const char*)g.A + (size_t)cur.pm * tstep; const char* cB = (const char*)g.Bt + (size_t)cur.pn * tstep;
    S.a_ready(cur);
    if constexpr (SP2) {
        PG8_STAGE(PG8_SB(0, 0), cB, voffB); PG8_STAGE(PG8_SB(0, 1), cB + hstep, voffB); PG8_STAGE(PG8_SA(0, 0), cA, voffA); PG8_STAGE(PG8_SA(0, 1), cA + hstep, voffA);
        if (wr == 1) PG8_BAR;
        PG8_WAIT_V(2); PG8_BAR;
        PG8_STAGE(PG8_SB(1, 0), cB + kstep, voffB); PG8_STAGE(PG8_SA(1, 0), cA + kstep, voffA); PG8_STAGE(PG8_SB(1, 1), cB + hstep + kstep, voffB);
        PG8_WAIT_V(6); PG8_BAR;
    } else {
        PG8_STAGE(PG8_SB(0, 0), cB, voffB); PG8_STAGE(PG8_SA(0, 0), cA, voffA); PG8_STAGE(PG8_SB(0, 1), cB + hstep, voffB); PG8_STAGE(PG8_SA(0, 1), cA + hstep, voffA);
        if (wr == 1) PG8_BAR;
        PG8_WAIT_V(4); PG8_BAR;
        PG8_STAGE(PG8_SB(1, 0), cB + kstep, voffB); PG8_STAGE(PG8_SA(1, 0), cA + kstep, voffA); PG8_STAGE(PG8_SB(1, 1), cB + hstep + kstep, voffB);
        PG8_WAIT_V(6); PG8_BAR;
    }
    for (;;) {
        const bool has_next = S.next(ui + 1, nxt);
        const char* nA = has_next ? (const char*)g.A + (size_t)nxt.pm * tstep : cA; const char* nB = has_next ? (const char*)g.Bt + (size_t)nxt.pn * tstep : cB;
        for (int t = 0; t < nt; t += 2) {
            const bool last = (t == nt - 2);
            const char* a1 = cA + (size_t)(t + 1) * kstep;
            const char* a2 = last ? nA : cA + (size_t)(t + 2) * kstep; const char* b2 = last ? nB : cB + (size_t)(t + 2) * kstep;
            const char* a3 = a2 + kstep; const char* b3 = b2 + kstep;
            if (last && has_next) S.a_ready(nxt);
            if constexpr (SP2) {
            PG8_LDB(B0, 0, 0); PG8_LDB(B1, 0, 1); PG8_SCHED; PG8_LDA(At, 0, 0); PG8_STAGE(PG8_SA(1, 1), a1 + hstep, voffA);
            PG8_WAIT_V(8); PG8_WAIT_L(0); PG8_BAR; PG8_MMA(0, 0, At, B0); PG8_MMA(0, 1, At, B1); PG8_BAR; PG8_SCHED;
            PG8_LDA(At, 0, 1); PG8_STAGE(PG8_SB(0, 0), b2, voffB); PG8_STAGE(PG8_SB(0, 1), b2 + hstep, voffB); PG8_STAGE(PG8_SA(0, 0), a2, voffA);
            PG8_WAIT_V(8); PG8_WAIT_L(0); PG8_BAR; PG8_MMA(1, 0, At, B0); PG8_MMA(1, 1, At, B1); PG8_BAR; PG8_SCHED;
            PG8_LDB(B0, 1, 0); PG8_LDB(B1, 1, 1); PG8_SCHED; PG8_LDA(At, 1, 0); PG8_STAGE(PG8_SA(0, 1), a2 + hstep, voffA);
            PG8_WAIT_V(8); PG8_WAIT_L(0); PG8_BAR; PG8_MMA(0, 0, At, B0); PG8_MMA(0, 1, At, B1); PG8_BAR; PG8_SCHED;
            PG8_LDA(At, 1, 1); PG8_STAGE(PG8_SB(1, 0), b3, voffB); PG8_STAGE(PG8_SB(1, 1), b3 + hstep, voffB); PG8_STAGE(PG8_SA(1, 0), a3, voffA);
            PG8_WAIT_V(8); PG8_WAIT_L(0); PG8_BAR; PG8_MMA(1, 0, At, B0); PG8_MMA(1, 1, At, B1); PG8_BAR; PG8_SCHED;
            } else {
            PG8_LDB(B0, 0, 0); PG8_SCHED; PG8_LDA(At, 0, 0); PG8_STAGE(PG8_SA(1, 1), a1 + hstep, voffA);
            PG8_WAIT_L(8); PG8_BAR; PG8_WAIT_L(0); PG8_MMA(0, 0, At, B0); PG8_BAR; PG8_SCHED;
            PG8_LDB(B1, 0, 1); PG8_STAGE(PG8_SB(0, 0), b2, voffB);
            PG8_BAR; PG8_WAIT_L(0); PG8_MMA(0, 1, At, B1); PG8_BAR;
            PG8_LDA(At, 0, 1); PG8_STAGE(PG8_SA(0, 0), a2, voffA);
            PG8_BAR; PG8_WAIT_L(0); PG8_MMA(1, 0, At, B0); PG8_BAR; PG8_SCHED;
            PG8_STAGE(PG8_SB(0, 1), b2 + hstep, voffB);
            PG8_WAIT_V(6); PG8_BAR; PG8_MMA(1, 1, At, B1); PG8_BAR;
            PG8_LDB(B0, 1, 0); PG8_SCHED; PG8_LDA(At, 1, 0); PG8_STAGE(PG8_SA(0, 1), a2 + hstep, voffA);
            PG8_WAIT_L(8); PG8_BAR; PG8_WAIT_L(0); PG8_MMA(0, 0, At, B0); PG8_BAR; PG8_SCHED;
            PG8_LDB(B1, 1, 1); PG8_STAGE(PG8_SB(1, 0), b3, voffB);
            PG8_BAR; PG8_WAIT_L(0); PG8_MMA(0, 1, At, B1); PG8_BAR;
            PG8_LDA(At, 1, 1); PG8_STAGE(PG8_SA(1, 0), a3, voffA);
            PG8_BAR; PG8_WAIT_L(0); PG8_MMA(1, 0, At, B0); PG8_BAR; PG8_SCHED;
            PG8_STAGE(PG8_SB(1, 1), b3 + hstep, voffB);
            PG8_WAIT_V(6); PG8_BAR; PG8_MMA(1, 1, At, B1); PG8_BAR;
            }
        }
        if constexpr (ALIGN_EPI) { if (wr == 0) PG8_BAR; }
        if constexpr (!Epi::AFTER_DRAIN) { E(acc, cur, wr, wc, fr, fq); S.done(cur); }
        if (!has_next) break;
#pragma unroll
        for (int a = 0; a < 2; ++a)
#pragma unroll
            for (int b = 0; b < 2; ++b)
#pragma unroll
                for (int m = 0; m < 4; ++m)
#pragma unroll
                    for (int n = 0; n < 2; ++n) acc[a][b][m][n] = (f32x4){0.f, 0.f, 0.f, 0.f};
        cur = nxt; cA = nA; cB = nB; ++ui;
        if constexpr (ALIGN_EPI) { if (wr == 1) PG8_BAR; }
    }
    PG8_WAIT_V(0);
    if constexpr (!ALIGN_EPI) { if (wr == 0) PG8_BAR; }
    PG8_BAR;
    if constexpr (Epi::AFTER_DRAIN) { E.fused(acc, cur, wr, wc, fr, fq, lds, wid, lane); S.done(cur); }
#undef PG8_SA
#undef PG8_SB
#undef PG8_STAGE
#undef PG8_LDA
#undef PG8_LDB
#undef PG8_MMA
#undef PG8_WAIT_V
#undef PG8_WAIT_L
#undef PG8_BAR
#undef PG8_SCHED
}
}
#define DI __device__ __forceinline__
#define LAS __attribute__((address_space(3)))
typedef unsigned short bf16;
typedef float f32x2v __attribute__((ext_vector_type(2)));
typedef float f32x4 __attribute__((ext_vector_type(4)));
typedef float f32x16 __attribute__((ext_vector_type(16)));
typedef short bf16x8 __attribute__((ext_vector_type(8)));
typedef short s16x4 __attribute__((ext_vector_type(4)));
typedef unsigned u32x4 __attribute__((ext_vector_type(4)));
typedef unsigned u32x2 __attribute__((ext_vector_type(2)));

constexpr int NB = 2, SEQ = 16384, CTXL = 256, DM = 1024, DEPTH = 2, INC = 2048, DFF = 4096;
constexpr int MLAT = NB * SEQ, MCTX = NB * CTXL, MTOT = MLAT + MCTX;
constexpr int SKV = CTXL + SEQ;
constexpr int NTILE64 = MTOT / 64;
constexpr int NCHUNK = SKV / 64;
constexpr float EPSN = 1e-6f;
constexpr int NTHR = 512, NWV = 8;
constexpr int LDS_BYTES = 147456;

constexpr size_t MiB = 1u << 20;
constexpr size_t WS_MOD = 1 * MiB;
constexpr size_t WS_POOLWT = 1 * MiB + 256 * 1024;
constexpr size_t WS_LRUWT = 1 * MiB + 384 * 1024;
constexpr size_t WS_WIN = 2 * MiB, WS_WOUT = 10 * MiB, WS_W1 = 14 * MiB, WS_W2 = 30 * MiB;
constexpr size_t WS_AGG = 46 * MiB;
constexpr size_t WS_CX = 49 * MiB;
constexpr size_t WS_H2 = 51 * MiB;
constexpr size_t WS_H2C = 59 * MiB;
constexpr size_t WS_W3T = 59 * MiB + 256 * 1024;
constexpr size_t WS_FTC = 60 * MiB;
constexpr size_t WS_QC = 61 * MiB;
constexpr size_t WS_XN = 62 * MiB;
constexpr size_t WS_MIX = 127 * MiB;
constexpr size_t WS_PX = 192 * MiB;
constexpr size_t WS_ZT = 322 * MiB;
constexpr size_t WS_ZTC = 370 * MiB;
constexpr size_t WS_Q = 371 * MiB;
constexpr size_t WS_K = 387 * MiB;
constexpr size_t WS_VT = 396 * MiB;
constexpr size_t WS_YDT = 405 * MiB;
constexpr size_t WS_YDTC = 421 * MiB;
constexpr size_t WS_FT = 422 * MiB;
constexpr size_t WS_CARRY = 486 * MiB;
constexpr size_t WS_END = 488 * MiB;

struct Args { const float* in[34]; float* out; unsigned char* ws; };

DI unsigned f2bf(float f) { unsigned u = __builtin_bit_cast(unsigned, f); return (u + 0x7fffu + ((u >> 16) & 1u)) >> 16; }
DI unsigned pk2(float lo, float hi) { return f2bf(lo) | (f2bf(hi) << 16); }
DI float bf2f(unsigned h) { return __builtin_bit_cast(float, h << 16); }
DI float bflo(unsigned w) { return __builtin_bit_cast(float, w << 16); }
DI float bfhi(unsigned w) { return __builtin_bit_cast(float, w & 0xffff0000u); }
DI float wave_sum(float v) {
#pragma unroll
    for (int o = 1; o < 64; o <<= 1) v += __shfl_xor(v, o);
    return v;
}
DI float sigmoidf_(float x) { return __builtin_amdgcn_rcpf(1.f + __expf(-x)); }
DI float gelu_tanh(float x) { const float u = 0.7978845608028654f * (x + 0.044715f * x * x * x); return x * __builtin_amdgcn_rcpf(1.f + __expf(-2.0f * u)); }
DI void unpack8(const u32x4 w, float* f) { f[0] = bflo(w.x); f[1] = bfhi(w.x); f[2] = bflo(w.y); f[3] = bfhi(w.y); f[4] = bflo(w.z); f[5] = bfhi(w.z); f[6] = bflo(w.w); f[7] = bfhi(w.w); }

struct Ctx {
    const float* const* in; float* out; unsigned char* ws; LAS unsigned char* lds;
    int tid, lane, wave, G, bid;
};
#define WSP(T, off) ((T*)(C.ws + (off)))
#define INP(i) (C.in[i])

DI void transpose_item(const float* W, int K, int N, bf16* WT, LAS float* scr, int item, int lane) {
    const int nblk = N / 32, kb = item / nblk, nb = item % nblk, k0 = 64 * kb, n0 = 32 * nb;
#pragma unroll
    for (int i = 0; i < 32; ++i) { const int kk = 2 * i + (lane >> 5); scr[kk * 33 + (lane & 31)] = W[(size_t)(k0 + kk) * N + n0 + (lane & 31)]; }
    asm volatile("s_waitcnt lgkmcnt(0)" ::: "memory");
    const int c = lane & 7;
#pragma unroll
    for (int j = 0; j < 4; ++j) { const int n = (lane >> 3) + 8 * j; const LAS float* s = scr + (8 * c) * 33 + n;
        u32x4 o; o.x = pk2(s[0 * 33], s[1 * 33]); o.y = pk2(s[2 * 33], s[3 * 33]); o.z = pk2(s[4 * 33], s[5 * 33]); o.w = pk2(s[6 * 33], s[7 * 33]);
        *(u32x4*)(WT + (size_t)(n0 + n) * K + k0 + 8 * c) = o; }
    asm volatile("s_waitcnt lgkmcnt(0)" ::: "memory");
}

DI void h2_item(Ctx& C, int l, int Lf, int t0, float* outp) {
    LAS float* emb = (LAS float*)C.lds;
    LAS float* h1s = emb + 64 * 33;
    LAS float* w1s = h1s + 64 * 65;
    LAS float* w2s = w1s + 33 * 64;
    const float* w1 = INP(25) + l * 33 * 64; const float* b1 = INP(26) + l * 64; const float* fq = INP(27) + l * 64;
    const float* w2 = INP(28) + l * 64 * 64; const float* b2 = INP(29) + l * 64;
    const int tid = C.tid;
#pragma unroll
    for (int i = 0; i < 5; ++i) { const int e = tid + NTHR * i; const float v = w1[e < 33 * 64 ? e : 0]; if (e < 33 * 64) w1s[e] = v; }
#pragma unroll
    for (int i = 0; i < 8; ++i) { const int e = tid + NTHR * i; w2s[e] = w2[e]; }
    for (int e = tid; e < 64 * 33; e += NTHR) { const int t2 = e / 33, i = e % 33, t = t0 + t2; float v;
        if (i == 0) v = (float)t / (float)(Lf - 1);
        else { const int bi = (i - 1) & 15; const float band = 1e-4f + (float)bi * ((15.0f - 1e-4f) / 15.0f);
            const float wv = (6.283185307179586f * (float)t) / (float)Lf; const float z = wv * band; v = (i <= 16) ? __cosf(z) : -__sinf(z); }
        emb[e] = v; }
    __syncthreads();
    const int tp = tid & 63, jg = tid >> 6;
    float a[8];
#pragma unroll
    for (int q = 0; q < 8; ++q) a[q] = b1[jg * 8 + q];
#pragma unroll 11
    for (int i = 0; i < 33; ++i) { const float ev = emb[tp * 33 + i];
#pragma unroll
        for (int q = 0; q < 8; ++q) a[q] += ev * w1s[i * 64 + jg * 8 + q]; }
#pragma unroll
    for (int q = 0; q < 8; ++q) h1s[tp * 65 + jg * 8 + q] = __sinf(fq[jg * 8 + q] * a[q]);
    __syncthreads();
#pragma unroll
    for (int q = 0; q < 8; ++q) a[q] = b2[jg * 8 + q];
#pragma unroll 8
    for (int i = 0; i < 64; ++i) { const float hv = h1s[tp * 65 + i];
#pragma unroll
        for (int q = 0; q < 8; ++q) a[q] += hv * w2s[i * 64 + jg * 8 + q]; }
    float o[8];
#pragma unroll
    for (int q = 0; q < 8; ++q) o[q] = __sinf(fq[jg * 8 + q] * a[q]);
    float* dst = outp + (size_t)(t0 + tp) * 64 + jg * 8;
    *(f32x4*)dst = (f32x4){o[0], o[1], o[2], o[3]}; *(f32x4*)(dst + 4) = (f32x4){o[4], o[5], o[6], o[7]};
    __syncthreads();
}

DI void phase0(Ctx& C) {
    const int gw = C.bid * NWV + C.wave, NGW = C.G * NWV;
    {
        LAS float* scr = (LAS float*)(C.lds + C.wave * 16384);
        constexpr int I_IN = 16 * 64, I_OUT = 16 * 32, I_1 = 16 * 128, I_2 = 64 * 32, PER = I_IN + I_OUT + I_1 + I_2;
        for (int it = gw; it < 2 * PER; it += NGW) {
            const int l = it / PER; int r = it % PER;
            if (r < I_IN) { transpose_item(INP(10) + (size_t)l * DM * INC, DM, INC, WSP(bf16, WS_WIN) + (size_t)l * INC * DM, scr, r, C.lane); continue; } r -= I_IN;
            if (r < I_OUT) { transpose_item(INP(11) + (size_t)l * DM * DM, DM, DM, WSP(bf16, WS_WOUT) + (size_t)l * DM * DM, scr, r, C.lane); continue; } r -= I_OUT;
            if (r < I_1) { transpose_item(INP(32) + (size_t)l * DM * DFF, DM, DFF, WSP(bf16, WS_W1) + (size_t)l * DFF * DM, scr, r, C.lane); continue; } r -= I_1;
            transpose_item(INP(33) + (size_t)l * DFF * DM, DFF, DM, WSP(bf16, WS_W2) + (size_t)l * DM * DFF, scr, r, C.lane);
        }
    }
    {
        const int gt = C.bid * NTHR + C.tid, NGT = C.G * NTHR;
        for (int e = gt; e < 2 * 4 * 4096; e += NGT) { const int m = e >> 12, n = (e >> 6) & 63, k = e & 63; WSP(bf16, WS_POOLWT)[e] = (bf16)f2bf(INP(12)[m * 4096 + k * 64 + n]); }
        for (int e = gt; e < 2 * 2 * 2 * 4 * 4096; e += NGT) {
            const int k = e & 63, n = (e >> 6) & 63, blk = (e >> 12) & 3, which = (e >> 14) & 1, d = (e >> 15) & 1, l = e >> 16;
            const float* src = which ? INP(20) : INP(18);
            WSP(bf16, WS_LRUWT)[e] = (bf16)f2bf(src[(((l * 2 + d) * 4 + blk) * 64 + k) * 64 + n]); }
        for (int e = gt; e < 2 * 65536; e += NGT) { const int k = e & 63, col = (e >> 6) & 1023, l = e >> 16; WSP(float, WS_W3T)[e] = INP(30)[(l * 64 + k) * 1024 + col]; }
    }
    __syncthreads();
    {
        LAS float* sc = (LAS float*)C.lds;
        LAS float* red = sc + 3 * 1024;
        for (int e = C.tid; e < 3 * 1024; e += NTHR) { const int i = e >> 10, k = e & 1023; const float v = (i < 2) ? INP(1)[i * 1024 + k] : INP(3)[k]; sc[e] = v / (1.f + __expf(-v)); }
        __syncthreads();
        for (int it = C.bid; it < 192; it += C.G) {
            const int l = it / 96, j = (it % 96) * 64 + C.lane; const float* wm = INP(4) + (size_t)l * DM * 6144 + j;
            float a0 = 0.f, a1 = 0.f, a2 = 0.f; const int kb = C.wave * 128;
#pragma unroll 32
            for (int k = kb; k < kb + 128; ++k) { const float w = wm[(size_t)k * 6144]; a0 += sc[k] * w; a1 += sc[1024 + k] * w; a2 += sc[2048 + k] * w; }
            red[(C.wave * 3 + 0) * 64 + C.lane] = a0; red[(C.wave * 3 + 1) * 64 + C.lane] = a1; red[(C.wave * 3 + 2) * 64 + C.lane] = a2;
            __syncthreads();
            if (C.tid < 192) { const int i = C.tid >> 6, ln = C.tid & 63; float s = 0.f;
                for (int w = 0; w < 8; ++w) s += red[(w * 3 + i) * 64 + ln];
                const int jj = (it % 96) * 64 + ln; WSP(float, WS_MOD)[(l * 3 + i) * 6144 + jj] = s + INP(5)[l * 6144 + jj]; }
            __syncthreads();
        }
    }
    for (int it = C.bid; it < 2 * 256 + 4; it += C.G) {
        if (it < 512) { const int l = it >> 8; h2_item(C, l, SEQ, (it & 255) * 64, WSP(float, WS_H2) + (size_t)l * SEQ * 64); }
        else h2_item(C, 0, CTXL, (it - 512) * 64, WSP(float, WS_H2C));
    }
}

DI int row_cond(int m) { return m < MLAT ? (m >> 14) : 2; }
DI void row_norm_mod(const float* xr, const float* g, const float* shift, const float* scale, bf16* xn, int lane) {
    f32x4 v[4]; float s = 0.f;
#pragma unroll
    for (int j = 0; j < 4; ++j) { v[j] = *(const f32x4*)(xr + 4 * lane + 256 * j); s += (v[j].x * v[j].x + v[j].y * v[j].y) + (v[j].z * v[j].z + v[j].w * v[j].w); }
    const float r = rsqrtf(wave_sum(s) * (1.f / DM) + EPSN);
#pragma unroll
    for (int j = 0; j < 4; ++j) { const int c = 4 * lane + 256 * j; const f32x4 gg = *(const f32x4*)(g + c), sh = *(const f32x4*)(shift + c), sc = *(const f32x4*)(scale + c);
        f32x4 o; o = (v[j] * r * gg) * (sc + 1.0f) + sh;
        u32x2 w; w.x = pk2(o.x, o.y); w.y = pk2(o.z, o.w); *(u32x2*)(xn + c) = w; }
}
template <int NR> DI void row_update(const float* const (&xi)[NR], const bf16* const (&y)[NR], const LAS float* gpost, const LAS float* gate, float* const (&xo)[NR], const LAS float* gnext, const LAS float* shift, const LAS float* scale, bf16* const (&xn)[NR], bool donext, int lane) {
    f32x4 yv[NR][4], xv[NR][4]; float s[NR];
#pragma unroll
    for (int q = 0; q < NR; ++q) { s[q] = 0.f;
#pragma unroll
        for (int j = 0; j < 4; ++j) { const u32x2 w = *(const u32x2*)(y[q] + 4 * lane + 256 * j); yv[q][j] = (f32x4){bflo(w.x), bfhi(w.x), bflo(w.y), bfhi(w.y)}; xv[q][j] = *(const f32x4*)(xi[q] + 4 * lane + 256 * j);
            s[q] += (yv[q][j].x * yv[q][j].x + yv[q][j].y * yv[q][j].y) + (yv[q][j].z * yv[q][j].z + yv[q][j].w * yv[q][j].w); } }
    float s2[NR];
#pragma unroll
    for (int q = 0; q < NR; ++q) { const float r = rsqrtf(wave_sum(s[q]) * (1.f / DM) + EPSN); s2[q] = 0.f;
#pragma unroll
        for (int j = 0; j < 4; ++j) { const int c = 4 * lane + 256 * j; const f32x4 gp = *(const LAS f32x4*)(gpost + c), ga = *(const LAS f32x4*)(gate + c);
            xv[q][j] = xv[q][j] + ga * (yv[q][j] * r * gp); *(f32x4*)(xo[q] + c) = xv[q][j];
            s2[q] += (xv[q][j].x * xv[q][j].x + xv[q][j].y * xv[q][j].y) + (xv[q][j].z * xv[q][j].z + xv[q][j].w * xv[q][j].w); } }
    if (donext) {
#pragma unroll
        for (int q = 0; q < NR; ++q) { const float r2 = rsqrtf(wave_sum(s2[q]) * (1.f / DM) + EPSN);
#pragma unroll
            for (int j = 0; j < 4; ++j) { const int c = 4 * lane + 256 * j; const f32x4 gg = *(const LAS f32x4*)(gnext + c), sh = *(const LAS f32x4*)(shift + c), sc = *(const LAS f32x4*)(scale + c);
                const f32x4 o = (xv[q][j] * r2 * gg) * (sc + 1.0f) + sh; u32x2 w; w.x = pk2(o.x, o.y); w.y = pk2(o.z, o.w); *(u32x2*)(xn[q] + c) = w; } }
    }
}

DI void ft_item(Ctx& C, const float* H2, const float* W3T, float* FT, int Lf, int n0) {
    LAS float* wl = (LAS float*)C.lds;
    const int n = n0 + C.lane; float h[64];
#pragma unroll
    for (int i = 0; i < 16; ++i) { const f32x4 v = *(const f32x4*)(H2 + (size_t)n * 64 + 4 * i); h[4 * i] = v.x; h[4 * i + 1] = v.y; h[4 * i + 2] = v.z; h[4 * i + 3] = v.w; }
    const float t01 = (float)n / (float)(Lf - 1);
    const int wv = __builtin_amdgcn_readfirstlane(C.wave);
#pragma unroll 1
    for (int half = 0; half < 2; ++half) {
        __syncthreads();
#pragma unroll 16
        for (int e = C.tid; e < 512 * 16; e += NTHR) *(LAS f32x4*)(wl + 4 * e) = *(const f32x4*)(W3T + (size_t)half * 32768 + 4 * e);
        __syncthreads();
#pragma unroll 2
        for (int ci = 0; ci < 64; ++ci) {
            const int cl = wv * 64 + ci, col = half * 512 + cl; const LAS float* wc = wl + cl * 64; float a = 0.f;
#pragma unroll
            for (int k4 = 0; k4 < 16; ++k4) { const f32x4 w4 = *(const LAS f32x4*)(wc + 4 * k4); a += h[4 * k4] * w4.x; a += h[4 * k4 + 1] * w4.y; a += h[4 * k4 + 2] * w4.z; a += h[4 * k4 + 3] * w4.w; }
            const int c = col & 255, o = (col >> 8) & 1, dir = col >> 9;
            const float delta = 3.0701134573253944f + (float)c * ((15.350567286626972f - 3.0701134573253944f) / 255.0f);
            FT[(size_t)((o * 2 + dir) * 256 + c) * Lf + n] = a * __expf(-t01 * delta);
        }
    }
    __syncthreads();
}
struct Tile { int b, p0, Ls, m0, lat; };
DI Tile tile_of(int tt) { Tile t; if (tt < 512) { t.lat = 1; t.b = tt >> 8; t.p0 = (tt & 255) * 64; t.Ls = SEQ; t.m0 = t.b * SEQ + t.p0; } else { const int u = tt - 512; t.lat = 0; t.b = u >> 2; t.p0 = (u & 3) * 64; t.Ls = CTXL; t.m0 = MLAT + t.b * CTXL + t.p0; } return t; }

DI void head_norm_rope(const bf16* src, const float* g, int a, int pos, bool rope, float oscale, bf16* dst) {
    float v[32];
#pragma unroll
    for (int i = 0; i < 4; ++i) unpack8(*(const u32x4*)(src + 8 * i), v + 8 * i);
    float ss = 0.f;
#pragma unroll
    for (int i = 0; i < 32; ++i) ss += v[i] * v[i];
    ss += __shfl_xor(ss, 1);
    const float r = rsqrtf(ss * (1.f / 64.f) + EPSN);
#pragma unroll
    for (int i = 0; i < 32; ++i) v[i] = v[i] * r * g[a * 32 + i];
    if (rope) {
        const float coord = (float)(a == 0 ? (pos >> 6) : (pos & 63));
#pragma unroll
        for (int f = 0; f < 16; ++f) { const float inv = exp2f(-(float)f * (13.287712379549449f / 16.0f)); const float ang = coord * inv; const float sn = __sinf(ang), cs = __cosf(ang);
            const float t1 = v[f], t2 = v[16 + f]; v[f] = t1 * cs - t2 * sn; v[16 + f] = t2 * cs + t1 * sn; }
    }
#pragma unroll
    for (int i = 0; i < 4; ++i) { u32x4 w; w.x = pk2(v[8 * i] * oscale, v[8 * i + 1] * oscale); w.y = pk2(v[8 * i + 2] * oscale, v[8 * i + 3] * oscale); w.z = pk2(v[8 * i + 4] * oscale, v[8 * i + 5] * oscale); w.w = pk2(v[8 * i + 6] * oscale, v[8 * i + 7] * oscale);
        *(u32x4*)(dst + 8 * i) = w; }
}

DI void prep_qkv(Ctx& C, int l, const Tile& T) {
    const bf16* PX = WSP(bf16, WS_PX); int tid = C.tid; asm volatile("" : "+v"(tid));
    LAS bf16* vs = (LAS bf16*)C.lds;
    {
        const int tok = tid >> 3, part = tid & 7, head = part >> 1, a = part & 1, pos = T.p0 + tok;
        const bf16* src = PX + (size_t)(T.m0 + tok) * INC + 256 + head * 64 + a * 32;
        bf16* dst = T.lat ? WSP(bf16, WS_Q) + ((size_t)(T.b * 4 + head) * SEQ + pos) * 64 + a * 32 : WSP(bf16, WS_QC) + ((size_t)(T.b * 4 + head) * CTXL + pos) * 64 + a * 32;
        head_norm_rope(src, INP(14) + l * 64, a, pos, T.lat != 0, 0.125f * 1.4426950408889634f, dst);
    }
    if (tid < 256) {
        const int tok = tid >> 2, part = tid & 3, head = part >> 1, a = part & 1, pos = T.p0 + tok;
        const bf16* src = PX + (size_t)(T.m0 + tok) * INC + 512 + head * 64 + a * 32;
        bf16* dst = WSP(bf16, WS_K) + ((size_t)(T.b * 2 + head) * SKV + (T.lat ? CTXL + pos : pos)) * 64 + a * 32;
        head_norm_rope(src, INP(15) + l * 64, a, pos, T.lat != 0, 1.0f, dst);
    } else {
        const int u = tid - 256;
#pragma unroll
        for (int i = 0; i < 4; ++i) { const int e = u + 256 * i, tok = e >> 4, ch = e & 15;
            const u32x4 w = *(const u32x4*)(PX + (size_t)(T.m0 + tok) * INC + 640 + ch * 8);
            *(LAS u32x4*)(vs + tok * 136 + ch * 8) = w; }
    }
    __syncthreads();
#pragma unroll
    for (int i = 0; i < 2; ++i) { const int task = tid + 512 * i, d = task >> 3, chunk = task & 7; unsigned short e[8];
#pragma unroll
        for (int j = 0; j < 8; ++j) e[j] = vs[(chunk * 8 + j) * 136 + d];
        u32x4 w; w.x = e[0] | ((unsigned)e[1] << 16); w.y = e[2] | ((unsigned)e[3] << 16); w.z = e[4] | ((unsigned)e[5] << 16); w.w = e[6] | ((unsigned)e[7] << 16);
        const int kvh = d >> 6, dd = d & 63;
        *(u32x4*)(WSP(bf16, WS_VT) + ((size_t)(T.b * 2 + kvh) * 64 + dd) * SKV + (T.lat ? CTXL + T.p0 : T.p0) + chunk * 8) = w; }
    __syncthreads();
}

DI void prep_hyena(Ctx& C, int l, const Tile& T, int gsel) {
    const bf16* PX = WSP(bf16, WS_PX); int tid = C.tid; asm volatile("" : "+v"(tid));
    LAS bf16* ts = (LAS bf16*)C.lds;
    {
        u32x4 w[5];
#pragma unroll
        for (int i = 0; i < 5; ++i) { const int e0 = tid + 512 * i, e = e0 < 66 * 32 ? e0 : 66 * 32 - 1; const int r = e >> 5, ch = e & 31, p = T.p0 - 1 + r; const bool ok = (p >= 0 && p < T.Ls); const int pc = ok ? p : T.p0;
            w[i] = *(const u32x4*)(PX + (size_t)(T.m0 - T.p0 + pc) * INC + 1280 + gsel * 256 + ch * 8); if (!ok) w[i] = (u32x4){0u, 0u, 0u, 0u}; }
#pragma unroll
        for (int i = 0; i < 5; ++i) { const int e = tid + 512 * i; if (e < 66 * 32) *(LAS u32x4*)(ts + (e >> 5) * 264 + (e & 31) * 8) = w[i]; }
    }
    __syncthreads();
    const float* cw = INP(23) + l * 3 * 768; const float* cb = INP(24) + l * 768;
#pragma unroll
    for (int i = 0; i < 4; ++i) { const int task = tid + 512 * i, col = task & 255, chunk = task >> 8, ci = gsel * 256 + col;
        const float w0 = cw[ci], w1 = cw[768 + ci], w2 = cw[1536 + ci], bb = cb[ci]; float x[10];
#pragma unroll
        for (int j = 0; j < 10; ++j) x[j] = bf2f(ts[(chunk * 8 + j) * 264 + col]);
        float o[8];
#pragma unroll
        for (int j = 0; j < 8; ++j) o[j] = bb + w0 * x[j] + w1 * x[j + 1] + w2 * x[j + 2];
        u32x4 w; w.x = pk2(o[0], o[1]); w.y = pk2(o[2], o[3]); w.z = pk2(o[4], o[5]); w.w = pk2(o[6], o[7]);
        bf16* dst = T.lat ? WSP(bf16, WS_ZT) + ((size_t)(T.b * 768 + ci)) * SEQ + T.p0 + chunk * 8 : WSP(bf16, WS_ZTC) + ((size_t)(T.b * 768 + ci)) * CTXL + T.p0 + chunk * 8;
        *(u32x4*)dst = w; }
    __syncthreads();
}

DI void prep_pool(Ctx& C, int l, const Tile& T) {
    const bf16* PX = WSP(bf16, WS_PX); int tid = C.tid; asm volatile("" : "+v"(tid));
    LAS float* us = (LAS float*)C.lds;
    LAS bf16* dt = (LAS bf16*)(C.lds + 80 * 256 * 4);
    {
        u32x4 w[5];
#pragma unroll
        for (int i = 0; i < 5; ++i) { const int e = tid + 512 * i, r = e >> 5, ch = e & 31, p = T.p0 - 8 + r; const bool ok = (p >= 0 && p < T.Ls); const int pc = ok ? p : T.p0;
            w[i] = *(const u32x4*)(PX + (size_t)(T.m0 - T.p0 + pc) * INC + ch * 8); if (!ok) w[i] = (u32x4){0u, 0u, 0u, 0u}; }
#pragma unroll
        for (int i = 0; i < 5; ++i) { const int e = tid + 512 * i, r = e >> 5, ch = e & 31; float f[8]; unpack8(w[i], f);
#pragma unroll
            for (int j = 0; j < 8; ++j) us[r * 256 + ch * 8 + j] = f[j]; }
    }
    __syncthreads();
    {
        const int col = tid & 255, th = tid >> 8, g = col >> 6, half = 1 << g;
        const int j0 = th * 32; float s = 0.f;
        for (int q = j0 - half; q < j0 + half; ++q) s += us[(q + 8) * 256 + col];
#pragma unroll 4
        for (int j = j0; j < j0 + 32; ++j) {
            const int p = T.p0 + j; int lo = p - half; if (lo < 0) lo = 0; int hi = p + half; if (hi > T.Ls) hi = T.Ls;
            const float d = s * __builtin_amdgcn_rcpf((float)(hi - lo)) - us[(j + 8) * 256 + col];
            dt[j * 264 + col] = (bf16)f2bf(d);
            s += us[(j + half + 8) * 256 + col] - us[(j - half + 8) * 256 + col];
        }
    }
    __syncthreads();
    {
        const int w = C.wave, g = w >> 1, th = w & 1, lane = tid & 63, rr = lane & 15, quad = lane >> 4;
        const bf16* WT = WSP(bf16, WS_POOLWT) + (size_t)(l * 4 + g) * 4096;
        bf16x8 af[2][2];
#pragma unroll
        for (int mt = 0; mt < 2; ++mt)
#pragma unroll
            for (int ks = 0; ks < 2; ++ks) af[mt][ks] = *(const LAS bf16x8*)(dt + (th * 32 + mt * 16 + rr) * 264 + g * 64 + ks * 32 + quad * 8);
#pragma unroll
        for (int nt = 0; nt < 4; ++nt) {
            bf16x8 bfr[2];
#pragma unroll
            for (int ks = 0; ks < 2; ++ks) bfr[ks] = *(const bf16x8*)(WT + (nt * 16 + rr) * 64 + ks * 32 + quad * 8);
            const int oc = g * 64 + nt * 16 + rr; const float psc = INP(13)[l * 256 + oc];
#pragma unroll
            for (int mt = 0; mt < 2; ++mt) { f32x4 acc = (f32x4){0.f, 0.f, 0.f, 0.f};
#pragma unroll
                for (int ks = 0; ks < 2; ++ks) acc = __builtin_amdgcn_mfma_f32_16x16x32_bf16(af[mt][ks], bfr[ks], acc, 0, 0, 0);
#pragma unroll
                for (int j = 0; j < 4; ++j) { const int tok = th * 32 + mt * 16 + quad * 4 + j; WSP(bf16, WS_MIX)[(size_t)(T.m0 + tok) * DM + oc] = (bf16)f2bf(acc[j] * psc); } }
        }
    }
    __syncthreads();
}

template <int PH> DI void lru_item(Ctx& C, int l, const Tile& T, int nb) {
    const bf16* PX = WSP(bf16, WS_PX); int tid = C.tid; asm volatile("" : "+v"(tid)); const int lane = tid & 63;
    LAS float* xcf = (LAS float*)C.lds;
    LAS bf16* xcb = (LAS bf16*)(C.lds + 64 * 65 * 4);
    LAS float* as_ = (LAS float*)(C.lds + 32768);
    LAS float* bs_ = as_ + 2 * 64 * 64;
    {
        const int tok = tid >> 3, c8 = tid & 7, p = T.p0 + tok, ch0 = nb * 64 + c8 * 8; float acc[8];
        const float* cw = INP(16) + l * 4 * 256; const float* cb = INP(17) + l * 256;
#pragma unroll
        for (int j = 0; j < 8; ++j) acc[j] = cb[ch0 + j];
#pragma unroll
        for (int k = 0; k < 4; ++k) { const int q = p + k - 2;
            if (q >= 0 && q < T.Ls) { float f[8]; unpack8(*(const u32x4*)(PX + (size_t)(T.m0 - T.p0 + q) * INC + 768 + ch0), f);
#pragma unroll
                for (int j = 0; j < 8; ++j) acc[j] += cw[k * 256 + ch0 + j] * f[j]; } }
#pragma unroll
        for (int j = 0; j < 8; ++j) xcf[tok * 65 + c8 * 8 + j] = acc[j];
        u32x4 w; w.x = pk2(acc[0], acc[1]); w.y = pk2(acc[2], acc[3]); w.z = pk2(acc[4], acc[5]); w.w = pk2(acc[6], acc[7]);
        *(LAS u32x4*)(xcb + tok * 72 + c8 * 8) = w;
    }
    __syncthreads();
    {
        const int w = C.wave, dir = w >> 2, tq = w & 3, rr = lane & 15, quad = lane >> 4;
        bf16x8 af[2];
#pragma unroll
        for (int ks = 0; ks < 2; ++ks) af[ks] = *(const LAS bf16x8*)(xcb + (tq * 16 + rr) * 72 + ks * 32 + quad * 8);
        const bf16* WA = WSP(bf16, WS_LRUWT) + (size_t)((((l * 2 + dir) * 2 + 0) * 4 + nb)) * 4096;
        const bf16* WX = WSP(bf16, WS_LRUWT) + (size_t)((((l * 2 + dir) * 2 + 1) * 4 + nb)) * 4096;
#pragma unroll
        for (int nt = 0; nt < 4; ++nt) {
            f32x4 ar = (f32x4){0.f, 0.f, 0.f, 0.f}, ai = (f32x4){0.f, 0.f, 0.f, 0.f};
#pragma unroll
            for (int ks = 0; ks < 2; ++ks) { const bf16x8 ba = *(const bf16x8*)(WA + (nt * 16 + rr) * 64 + ks * 32 + quad * 8), bx = *(const bf16x8*)(WX + (nt * 16 + rr) * 64 + ks * 32 + quad * 8);
                ar = __builtin_amdgcn_mfma_f32_16x16x32_bf16(af[ks], ba, ar, 0, 0, 0); ai = __builtin_amdgcn_mfma_f32_16x16x32_bf16(af[ks], bx, ai, 0, 0, 0); }
            const int chl = nt * 16 + rr, ch = nb * 64 + chl; const int pi = (l * 2 + dir) * 256 + ch;
            const float br = INP(19)[pi], bi = INP(21)[pi], lam = INP(22)[pi]; const float sp = log1pf(__expf(-lam));
#pragma unroll
            for (int j = 0; j < 4; ++j) { const int tok = tq * 16 + quad * 4 + j;
                const float r = sigmoidf_(ar[j] + br), ig = sigmoidf_(ai[j] + bi); const float la = -8.0f * r * sp; const float a = __expf(la);
                const float bcoef = __builtin_amdgcn_sqrtf(fmaxf(-expm1f(2.0f * la), 0.f)) * (ig * xcf[tok * 65 + chl]);
                as_[(dir * 64 + tok) * 64 + chl] = a; bs_[(dir * 64 + tok) * 64 + chl] = bcoef; }
        }
    }
    __syncthreads();
    const int cid = T.lat ? 4 + (T.p0 >> 6) : (T.p0 >> 6);
    float* AGG = WSP(float, WS_AGG);
    if (tid < 128) {
        const int dir = tid >> 6, chl = tid & 63, ch = nb * 64 + chl; float h = 0.f;
        if (PH == 2) h = WSP(float, WS_CARRY)[(size_t)(T.b * NCHUNK + cid) * 512 + dir * 256 + ch];
        float A = 1.f;
        if (dir == 0) {
#pragma unroll 16
            for (int t = 0; t < 64; ++t) { const float a = as_[(dir * 64 + t) * 64 + chl], b = bs_[(dir * 64 + t) * 64 + chl]; h = a * h + b; A *= a; if (PH == 2) bs_[(dir * 64 + t) * 64 + chl] = h; } }
        else {
#pragma unroll 16
            for (int t = 63; t >= 0; --t) { const float a = as_[(dir * 64 + t) * 64 + chl], b = bs_[(dir * 64 + t) * 64 + chl]; h = a * h + b; A *= a; if (PH == 2) bs_[(dir * 64 + t) * 64 + chl] = h; } }
        if (PH == 1) { float* ag = AGG + ((size_t)(T.b * NCHUNK + cid) * 2 + dir) * 512 + ch; ag[0] = A; ag[256] = h; }
    }
    __syncthreads();
    if (PH == 2) {
        const int tok = tid >> 3, c8 = tid & 7, ch0 = nb * 64 + c8 * 8; float g[8], o[8];
        unpack8(*(const u32x4*)(PX + (size_t)(T.m0 + tok) * INC + 1024 + ch0), g);
#pragma unroll
        for (int j = 0; j < 8; ++j) o[j] = (bs_[tok * 64 + c8 * 8 + j] + bs_[(64 + tok) * 64 + c8 * 8 + j]) * gelu_tanh(g[j]);
        u32x4 w; w.x = pk2(o[0], o[1]); w.y = pk2(o[2], o[3]); w.z = pk2(o[4], o[5]); w.w = pk2(o[6], o[7]);
        *(u32x4*)(WSP(bf16, WS_MIX) + (size_t)(T.m0 + tok) * DM + 512 + ch0) = w;
        __syncthreads();
    }
}

DI void lru_carry(Ctx& C) {
    if (C.bid >= 16) return;
    const int b = C.bid >> 3, dir = (C.bid >> 2) & 1, ch = (C.bid & 3) * 64 + C.lane, w = C.wave;
    const float* ag = WSP(float, WS_AGG) + (size_t)b * NCHUNK * 1024 + dir * 512 + ch;
    float* cr = WSP(float, WS_CARRY) + (size_t)b * NCHUNK * 512 + dir * 256 + ch;
    LAS float* sa = (LAS float*)C.lds; LAS float* sb = sa + 8 * 64;
    constexpr int SEG = 33;
    const int s0 = w * SEG; float a[SEG], bq[SEG];
#pragma unroll
    for (int i = 0; i < SEG; ++i) { const int s = s0 + i; const int cid = dir == 0 ? s : (s < 4 ? 3 - s : NCHUNK + 3 - s);
        if (s < NCHUNK) { a[i] = ag[(size_t)cid * 1024]; bq[i] = ag[(size_t)cid * 1024 + 256]; } else { a[i] = 1.f; bq[i] = 0.f; } }
    float A = 1.f, B = 0.f;
#pragma unroll
    for (int i = 0; i < SEG; ++i) { B = a[i] * B + bq[i]; A *= a[i]; }
    sa[w * 64 + C.lane] = A; sb[w * 64 + C.lane] = B;
    __syncthreads();
    float h = 0.f;
    for (int w2 = 0; w2 < w; ++w2) h = sa[w2 * 64 + C.lane] * h + sb[w2 * 64 + C.lane];
#pragma unroll
    for (int i = 0; i < SEG; ++i) { const int s = s0 + i; const int cid = dir == 0 ? s : (s < 4 ? 3 - s : NCHUNK + 3 - s);
        if (s < NCHUNK) { cr[(size_t)cid * 512] = h; h = a[i] * h + bq[i]; } }
    __syncthreads();
}
DI float max3f(float a, float b, float c) { float r; asm("v_max3_f32 %0, %1, %2, %3" : "=v"(r) : "v"(a), "v"(b), "v"(c)); return r; }
DI int crow(int r, int hi) { return (r & 3) + 8 * (r >> 2) + 4 * hi; }
DI unsigned cvtpk(float lo, float hi) { typedef __bf16 bf16x2_t __attribute__((ext_vector_type(2))); f32x2v v = {lo, hi}; bf16x2_t b = __builtin_convertvector(v, bf16x2_t); return __builtin_bit_cast(unsigned, b); }
DI void attn_unit(Ctx& C, const bf16* Qp, const bf16* Kp, const bf16* VTp, int NT, bf16* Op, int q0, int nrows) {
    int tid = C.tid; asm volatile("" : "+v"(tid)); const int lane = tid & 63, w = C.wave, r = lane & 31, hi = lane >> 5;
    LAS unsigned char* Ks = C.lds;
    LAS unsigned char* Vs = C.lds + 2 * 9216;
    LAS float* wsf = (LAS float*)(C.lds + 4 * 9216) + w * 64;
    bf16x8 qf[2][4];
#pragma unroll
    for (int g = 0; g < 2; ++g)
#pragma unroll
        for (int d0 = 0; d0 < 4; ++d0) qf[g][d0] = *(const bf16x8*)(Qp + (size_t)(q0 + w * 64 + g * 32 + r) * 64 + d0 * 16 + hi * 8);
    const int srow = tid >> 3, sch = tid & 7;
    u32x4 kreg = *(const u32x4*)(Kp + (size_t)tid * 8);
    u32x4 vreg = *(const u32x4*)(VTp + (size_t)srow * SKV + sch * 8);
    *(LAS u32x4*)(Ks + srow * 144 + sch * 16) = kreg; *(LAS u32x4*)(Vs + srow * 144 + sch * 16) = vreg;
    __syncthreads();
    f32x16 o[2][2];
#pragma unroll
    for (int g = 0; g < 2; ++g)
#pragma unroll
        for (int i = 0; i < 16; ++i) { o[g][0][i] = 0.f; o[g][1][i] = 0.f; }
    float m[2] = {0.f, 0.f}, lsum[2] = {0.f, 0.f};
    bool anym = false;
    for (int t = 0; t < NT; ++t) {
        const int cur = t & 1; const bool more = (t + 1 < NT);
        if (more) { kreg = *(const u32x4*)(Kp + (size_t)(t + 1) * 4096 + (size_t)tid * 8); vreg = *(const u32x4*)(VTp + (size_t)srow * SKV + (t + 1) * 64 + sch * 8); }
        const LAS unsigned char* kb = Ks + cur * 9216 + r * 144 + hi * 16;
        const LAS unsigned char* vb = Vs + cur * 9216 + r * 144 + hi * 8;
        f32x16 p[2][2]; u32x4 pa[2][2][2]; bf16x8 kf[2][4];
        const f32x16 z = {0.f, 0.f, 0.f, 0.f, 0.f, 0.f, 0.f, 0.f, 0.f, 0.f, 0.f, 0.f, 0.f, 0.f, 0.f, 0.f};
#pragma unroll
        for (int d0 = 0; d0 < 4; ++d0) { kf[0][d0] = *(const LAS bf16x8*)(kb + d0 * 32); kf[1][d0] = *(const LAS bf16x8*)(kb + 32 * 144 + d0 * 32); }
#define ATT_QK(g) do { _Pragma("unroll") for (int d0 = 0; d0 < 4; ++d0) { \
            p[g][0] = __builtin_amdgcn_mfma_f32_32x32x16_bf16(kf[0][d0], qf[g][d0], d0 == 0 ? z : p[g][0], 0, 0, 0); \
            p[g][1] = __builtin_amdgcn_mfma_f32_32x32x16_bf16(kf[1][d0], qf[g][d0], d0 == 0 ? z : p[g][1], 0, 0, 0); } } while (0)
#define MX3(a, b, c) fmaxf(fmaxf((a), (b)), (c))
#define ATT_MAX(g) do { float mx = MX3(p[g][0][0], p[g][1][0], p[g][0][1]), mx2 = MX3(p[g][1][1], p[g][0][2], p[g][1][2]); \
            _Pragma("unroll") for (int i = 3; i < 15; i += 2) { mx = MX3(mx, p[g][0][i], p[g][1][i]); mx2 = MX3(mx2, p[g][0][i + 1], p[g][1][i + 1]); } \
            mx = MX3(mx, p[g][0][15], p[g][1][15]); mx = fmaxf(mx, mx2); \
            mx = fmaxf(mx, __shfl_xor(mx, 32)); \
            if (__builtin_expect(__any(mx > m[g] + 16.0f), 0)) {      \
                const float dl = fmaxf(mx - m[g], 0.f); m[g] += dl; const float alpha = __builtin_amdgcn_exp2f(-dl); lsum[g] *= alpha; anym = true; \
                if (hi == 0) wsf[g * 32 + r] = alpha; \
                _Pragma("unroll") for (int i = 0; i < 16; ++i) { const float f = wsf[g * 32 + crow(i, hi)]; o[g][0][i] *= f; o[g][1][i] *= f; } } \
            if (__builtin_expect(anym, 0)) { const float mg = m[g];         \
                _Pragma("unroll") for (int i = 0; i < 16; ++i) { p[g][0][i] -= mg; p[g][1][i] -= mg; } } } while (0)
#define ATT_EXP(g) do { float ps = 0.f; \
            _Pragma("unroll") for (int i = 0; i < 16; ++i) { p[g][0][i] = __builtin_amdgcn_exp2f(p[g][0][i]); p[g][1][i] = __builtin_amdgcn_exp2f(p[g][1][i]); ps += p[g][0][i] + p[g][1][i]; } \
            lsum[g] += ps; \
            _Pragma("unroll") for (int kbk = 0; kbk < 2; ++kbk) _Pragma("unroll") for (int s = 0; s < 2; ++s) \
                pa[g][kbk][s] = (u32x4){cvtpk(p[g][kbk][8 * s], p[g][kbk][8 * s + 1]), cvtpk(p[g][kbk][8 * s + 2], p[g][kbk][8 * s + 3]), cvtpk(p[g][kbk][8 * s + 4], p[g][kbk][8 * s + 5]), cvtpk(p[g][kbk][8 * s + 6], p[g][kbk][8 * s + 7])}; } while (0)
#define ATT_PV(g) do { _Pragma("unroll") for (int kbk = 0; kbk < 2; ++kbk) _Pragma("unroll") for (int s = 0; s < 2; ++s) _Pragma("unroll") for (int db = 0; db < 2; ++db) \
            o[g][db] = __builtin_amdgcn_mfma_f32_32x32x16_bf16(__builtin_bit_cast(bf16x8, pa[g][kbk][s]), vf[kbk][s][db], o[g][db], 0, 0, 0); } while (0)
#define ATT_MIX(nv) do { _Pragma("unroll") for (int q_ = 0; q_ < 8; ++q_) { __builtin_amdgcn_sched_group_barrier(0x008, 1, 0); __builtin_amdgcn_sched_group_barrier(0x400, 4, 0); __builtin_amdgcn_sched_group_barrier(0x002, nv, 0); } } while (0)
        ATT_QK(0); ATT_MAX(0);
        asm volatile("" : "+v"(kf[0][0]), "+v"(kf[1][0]));
        ATT_QK(1); ATT_EXP(0); ATT_MIX(6);
        asm volatile("" : "+v"(pa[0][0][0]), "+v"(pa[0][0][1]), "+v"(pa[0][1][0]), "+v"(pa[0][1][1]), "+v"(lsum[0]));
        ATT_MAX(1);
        bf16x8 vf[2][2][2];
#pragma unroll
        for (int kbk = 0; kbk < 2; ++kbk)
#pragma unroll
            for (int s = 0; s < 2; ++s)
#pragma unroll
                for (int db = 0; db < 2; ++db) {
                    const s16x4 lo = *(const LAS s16x4*)(vb + db * 32 * 144 + (kbk * 32 + s * 16) * 2), hh = *(const LAS s16x4*)(vb + db * 32 * 144 + (kbk * 32 + s * 16 + 8) * 2);
                    vf[kbk][s][db] = (bf16x8){lo[0], lo[1], lo[2], lo[3], hh[0], hh[1], hh[2], hh[3]}; }
        ATT_PV(0); ATT_EXP(1); ATT_MIX(6);
        asm volatile("" : "+v"(pa[1][0][0]), "+v"(pa[1][0][1]), "+v"(pa[1][1][0]), "+v"(pa[1][1][1]), "+v"(lsum[1]));
        ATT_PV(1);
#undef ATT_QK
#undef ATT_MAX
#undef MX3
#undef ATT_EXP
#undef ATT_PV
#undef ATT_MIX
        if (more) { *(LAS u32x4*)(Ks + (cur ^ 1) * 9216 + srow * 144 + sch * 16) = kreg; *(LAS u32x4*)(Vs + (cur ^ 1) * 9216 + srow * 144 + sch * 16) = vreg; }
        __syncthreads();
    }
    const bool active = (w * 64 < nrows);
#pragma unroll
    for (int g = 0; g < 2; ++g) {
        float l = lsum[g]; l += __shfl_xor(l, 32);
        if (hi == 0) wsf[g * 32 + r] = 1.f / l;
        if (active) {
#pragma unroll
            for (int i = 0; i < 16; ++i) { const int q = crow(i, hi); const float f = wsf[g * 32 + q]; bf16* orow = Op + (size_t)(q0 + w * 64 + g * 32 + q) * DM;
                orow[r] = (bf16)f2bf(o[g][0][i] * f); orow[32 + r] = (bf16)f2bf(o[g][1][i] * f); }
        }
    }
    __syncthreads();
}

DI f32x2v cmul(f32x2v a, f32x2v b) { return (f32x2v){a.x * b.x - a.y * b.y, a.x * b.y + a.y * b.x}; }
DI int swz(int i) { return i ^ (((i >> 6) & 7) << 2); }
DI f32x2v cmulc(f32x2v a, f32x2v b) { return (f32x2v){a.x * b.x + a.y * b.y, a.y * b.x - a.x * b.y}; }
DI void bfly4f(f32x2v& a0, f32x2v& a1, f32x2v& a2, f32x2v& a3) {
    const f32x2v t0 = a0 + a2, t1 = a0 - a2, t2 = a1 + a3, d = a1 - a3; const f32x2v t3 = (f32x2v){d.y, -d.x};
    a0 = t0 + t2; a1 = t1 + t3; a2 = t0 - t2; a3 = t1 - t3;
}
DI void bfly4i(f32x2v& a0, f32x2v& a1, f32x2v& a2, f32x2v& a3) {
    const f32x2v s0 = a0 + a2, s1 = a0 - a2, s2 = a1 + a3, d = a1 - a3; const f32x2v s3 = (f32x2v){-d.y, d.x};
    a0 = s0 + s2; a1 = s1 + s3; a2 = s0 - s2; a3 = s1 - s3;
}
template <int T, bool INV> DI void fft_pass16(LAS f32x2v* buf, int tid) {
    asm volatile("" : "+v"(tid));
    constexpr float C1 = 0.9238795325112867f, S1 = 0.3826834323650898f, C2 = 0.7071067811865476f;
#pragma unroll 1
    for (int it = 0; it < 2; ++it) {
        const int j = tid + 512 * it, pos = j & (T - 1), base = ((j - pos) << 4) + pos;
        f32x2v e[16];
#pragma unroll
        for (int m = 0; m < 16; ++m) e[m] = buf[swz(base + m * T)];
        const float fr = (float)pos / (float)(16 * T);
        const f32x2v wp = (f32x2v){__builtin_amdgcn_cosf(fr), -__builtin_amdgcn_sinf(fr)};
        const f32x2v wp2 = cmul(wp, wp), wp4 = cmul(wp2, wp2);
        const f32x2v wp8 = cmul(wp4, wp4), wp12 = cmul(wp8, wp4);
        if (!INV) {
#pragma unroll
            for (int m = 0; m < 4; ++m) {
                const f32x2v c16 = (m == 0) ? (f32x2v){1.f, 0.f} : (m == 1) ? (f32x2v){C1, -S1} : (m == 2) ? (f32x2v){C2, -C2} : (f32x2v){S1, -C1};
                const f32x2v w1 = cmul(wp, c16), w2 = cmul(w1, w1), w3 = cmul(w2, w1);
                bfly4f(e[m], e[m + 4], e[m + 8], e[m + 12]);
                e[m + 4] = cmul(e[m + 4], w1); e[m + 8] = cmul(e[m + 8], w2); e[m + 12] = cmul(e[m + 12], w3);
            }
#pragma unroll
            for (int q = 0; q < 4; ++q) {
                bfly4f(e[4 * q], e[4 * q + 1], e[4 * q + 2], e[4 * q + 3]);
                e[4 * q + 1] = cmul(e[4 * q + 1], wp4); e[4 * q + 2] = cmul(e[4 * q + 2], wp8); e[4 * q + 3] = cmul(e[4 * q + 3], wp12);
            }
        } else {
#pragma unroll
            for (int q = 0; q < 4; ++q) {
                e[4 * q + 1] = cmulc(e[4 * q + 1], wp4); e[4 * q + 2] = cmulc(e[4 * q + 2], wp8); e[4 * q + 3] = cmulc(e[4 * q + 3], wp12);
                bfly4i(e[4 * q], e[4 * q + 1], e[4 * q + 2], e[4 * q + 3]);
            }
#pragma unroll
            for (int m = 0; m < 4; ++m) {
                const f32x2v c16 = (m == 0) ? (f32x2v){1.f, 0.f} : (m == 1) ? (f32x2v){C1, -S1} : (m == 2) ? (f32x2v){C2, -C2} : (f32x2v){S1, -C1};
                const f32x2v w1 = cmul(wp, c16), w2 = cmul(w1, w1), w3 = cmul(w2, w1);
                e[m + 4] = cmulc(e[m + 4], w1); e[m + 8] = cmulc(e[m + 8], w2); e[m + 12] = cmulc(e[m + 12], w3);
                bfly4i(e[m], e[m + 4], e[m + 8], e[m + 12]);
            }
        }
#pragma unroll
        for (int m = 0; m < 16; ++m) buf[swz(base + m * T)] = e[m];
    }
    __syncthreads();
}
template <bool INV> DI void fft_pass4_s1(LAS f32x2v* buf, int tid) {
    asm volatile("" : "+v"(tid));
#pragma unroll 2
    for (int it = 0; it < 8; ++it) {
        const int b = swz((tid + 512 * it) << 2);
        f32x2v a0 = buf[b], a1 = buf[b + 1], a2 = buf[b + 2], a3 = buf[b + 3];
        if (!INV) bfly4f(a0, a1, a2, a3); else bfly4i(a0, a1, a2, a3);
        buf[b] = a0; buf[b + 1] = a1; buf[b + 2] = a2; buf[b + 3] = a3;
    }
    __syncthreads();
}
DI void fft_fwd(LAS f32x2v* buf, int tid) { fft_pass16<1024, false>(buf, tid); fft_pass16<64, false>(buf, tid); fft_pass16<4, false>(buf, tid); fft_pass4_s1<false>(buf, tid); }
DI void fft_inv(LAS f32x2v* buf, int tid) { fft_pass4_s1<true>(buf, tid); fft_pass16<4, true>(buf, tid); fft_pass16<64, true>(buf, tid); fft_pass16<1024, true>(buf, tid); }

DI void hyena_unit(Ctx& C, int l, int c, f32x2v* park, int dry = 0) {
    LAS f32x2v* buf = (LAS f32x2v*)C.lds; LAS float* red = (LAS float*)(C.lds + 131072);
    int tid = C.tid; asm volatile("" : "+v"(tid));
    bf16* ZT = WSP(bf16, WS_ZT); const float* FT = WSP(float, WS_FT);
    bf16* u0 = ZT + (size_t)(0 * 768 + 512 + c) * SEQ; bf16* u1 = ZT + (size_t)(1 * 768 + 512 + c) * SEQ;
    f32x2v* spec = park + SEQ;
#pragma unroll 1
    for (int o = 0; o < 2; ++o) {
        const float* hf = FT + (size_t)((o * 2 + 0) * 256 + c) * SEQ; const float* hb = FT + (size_t)((o * 2 + 1) * 256 + c) * SEQ;
        const bf16* g0 = ZT + (size_t)(0 * 768 + o * 256 + c) * SEQ; const bf16* g1 = ZT + (size_t)(1 * 768 + o * 256 + c) * SEQ;
        const float skip = INP(31)[(l * 2 + o) * 256 + c];
        if (o == 0) {
#pragma unroll 32
            for (int n = tid; n < SEQ; n += NTHR) buf[swz(n)] = (f32x2v){bf2f(u0[n]), bf2f(u1[n])};
        }
        __syncthreads(); fft_fwd(buf, tid);
        float sabs = 0.f;
#pragma unroll 32
        for (int n = tid; n < SEQ; n += NTHR) spec[n] = buf[swz(n)];
#pragma unroll 32
        for (int n = tid; n < SEQ; n += NTHR) { const float a = hf[n], b = n ? hb[SEQ - n] : 0.f; sabs += fabsf(a) + fabsf(b); buf[swz(n)] = (f32x2v){a + b, 0.f}; }
        __syncthreads(); fft_fwd(buf, tid);
#pragma unroll 32
        for (int n = tid; n < SEQ; n += NTHR) { const int ns = swz(n); buf[ns] = cmul(buf[ns], spec[n]); }
        __syncthreads(); fft_inv(buf, tid);
#pragma unroll 32
        for (int n = tid; n < SEQ; n += NTHR) park[n] = buf[swz(n)];
#pragma unroll 32
        for (int n = tid; n < SEQ; n += NTHR) { const float fr = (float)n * (1.0f / 32768.0f); const f32x2v wv = (f32x2v){__builtin_amdgcn_cosf(fr), -__builtin_amdgcn_sinf(fr)};
            buf[swz(n)] = cmul((f32x2v){bf2f(u0[n]), bf2f(u1[n])}, wv); }
        __syncthreads(); fft_fwd(buf, tid);
#pragma unroll 32
        for (int n = tid; n < SEQ; n += NTHR) spec[n] = buf[swz(n)];
#pragma unroll 32
        for (int n = tid; n < SEQ; n += NTHR) { const float a = hf[n], b = n ? hb[SEQ - n] : 0.f; const float fr = (float)n * (1.0f / 32768.0f); const float d = a - b;
            buf[swz(n)] = (f32x2v){d * __builtin_amdgcn_cosf(fr), -d * __builtin_amdgcn_sinf(fr)}; }
        __syncthreads(); fft_fwd(buf, tid);
#pragma unroll 32
        for (int n = tid; n < SEQ; n += NTHR) { const int ns = swz(n); buf[ns] = cmul(buf[ns], spec[n]); }
        __syncthreads(); fft_inv(buf, tid);
        sabs = wave_sum(sabs); if (C.lane == 0) red[C.wave] = sabs;
        __syncthreads();
        float tot = 0.f;
#pragma unroll
        for (int w = 0; w < 8; ++w) tot += red[w];
        const float nrm = 1.0f / (32768.0f * tot);
#pragma unroll 1
        for (int n0 = tid; n0 < SEQ; n0 += 8 * NTHR) {
            f32x2v pk[8]; unsigned short r0[8], r1[8], q0[8], q1[8];
#pragma unroll
            for (int k = 0; k < 8; ++k) { const int n = n0 + NTHR * k; pk[k] = park[n]; r0[k] = u0[n]; r1[k] = u1[n]; q0[k] = g0[n]; q1[k] = g1[n]; }
#pragma unroll
            for (int k = 0; k < 8; ++k) { const int n = n0 + NTHR * k; const float fr = (float)n * (1.0f / 32768.0f); const f32x2v wc = (f32x2v){__builtin_amdgcn_cosf(fr), __builtin_amdgcn_sinf(fr)};
                const f32x2v cv = (pk[k] + cmul(buf[swz(n)], wc)) * nrm; const float x0 = bf2f(r0[k]), x1 = bf2f(r1[k]);
                const float y0 = bf2f(q0[k]) * (cv.x + skip * x0), y1 = bf2f(q1[k]) * (cv.y + skip * x1);
                if (dry) { if (y0 == 1.2345e30f) u0[n] = 0; }
                else if (o == 0) { const unsigned b0 = f2bf(y0), b1 = f2bf(y1); u0[n] = (bf16)b0; u1[n] = (bf16)b1; buf[swz(n)] = (f32x2v){bf2f(b0), bf2f(b1)}; }
                else { WSP(bf16, WS_YDT)[(size_t)(0 * 256 + c) * SEQ + n] = (bf16)f2bf(y0); WSP(bf16, WS_YDT)[(size_t)(1 * 256 + c) * SEQ + n] = (bf16)f2bf(y1); } }
        }
        __syncthreads();
    }
}

DI void hyena_ctx_unit(Ctx& C, int l, int c) {
    LAS float* hh = (LAS float*)C.lds; LAS float* us = hh + 512; LAS float* red = us + 512;
    int tid = C.tid; asm volatile("" : "+v"(tid)); const int b = tid >> 8, t = tid & 255; const bf16* ZTC = WSP(bf16, WS_ZTC); const float* FTC = WSP(float, WS_FTC);
    float u = bf2f(ZTC[(size_t)(b * 768 + 512 + c) * CTXL + t]);
    for (int o = 0; o < 2; ++o) {
        float av = 0.f;
        if (tid < 511) { const int i = tid - 255; const float v = (i >= 0) ? FTC[(size_t)((o * 2 + 0) * 256 + c) * CTXL + i] : FTC[(size_t)((o * 2 + 1) * 256 + c) * CTXL - i]; hh[tid] = v; av = fabsf(v); }
        us[b * 256 + t] = u;
        av = wave_sum(av); if ((tid & 63) == 0) red[tid >> 6] = av;
        __syncthreads();
        float tot = 0.f;
#pragma unroll
        for (int w = 0; w < 8; ++w) tot += red[w];
        float acc = 0.f;
#pragma unroll 16
        for (int s2 = 0; s2 < 256; ++s2) acc += hh[255 + t - s2] * us[b * 256 + s2];
        const float gate = bf2f(ZTC[(size_t)(b * 768 + o * 256 + c) * CTXL + t]); const float skip = INP(31)[(l * 2 + o) * 256 + c];
        u = gate * (acc / tot + skip * u);
        __syncthreads();
    }
    WSP(bf16, WS_YDTC)[(size_t)(b * 256 + c) * CTXL + t] = (bf16)f2bf(u);
}

DI void ydt_transpose(Ctx& C, const Tile& T) {
    LAS bf16* ts = (LAS bf16*)C.lds;
    int tid = C.tid; asm volatile("" : "+v"(tid));
#pragma unroll
    for (int i = 0; i < 4; ++i) { const int task = tid + 512 * i, ch = task >> 3, chunk = task & 7;
        const bf16* src = T.lat ? WSP(bf16, WS_YDT) + (size_t)(T.b * 256 + ch) * SEQ + T.p0 + chunk * 8 : WSP(bf16, WS_YDTC) + (size_t)(T.b * 256 + ch) * CTXL + T.p0 + chunk * 8;
        *(LAS u32x4*)(ts + ch * 72 + chunk * 8) = *(const u32x4*)src; }
    __syncthreads();
    const int tok = tid >> 3, cg8 = tid & 7;
#pragma unroll
    for (int q = 0; q < 4; ++q) { unsigned short e[8];
#pragma unroll
        for (int j = 0; j < 8; ++j) e[j] = ts[(cg8 * 32 + q * 8 + j) * 72 + tok];
        u32x4 w; w.x = e[0] | ((unsigned)e[1] << 16); w.y = e[2] | ((unsigned)e[3] << 16); w.z = e[4] | ((unsigned)e[5] << 16); w.w = e[6] | ((unsigned)e[7] << 16);
        *(u32x4*)(WSP(bf16, WS_MIX) + (size_t)(T.m0 + tok) * DM + 768 + cg8 * 32 + q * 8) = w; }
    __syncthreads();
}
#define XB_TMO      128
#define XB_XCNT(j)  (256  + 64 * (j))
#define XB_XSUB(j)  (1280 + 64 * (j))
#define XB_XGEN(j)  (2304 + 64 * (j))
#define XB_TOP      3328
#define XB_TOPGEN   3392
#define XCD_BAR_WORDS 3456
#define XB_SPIN_CAP (1u << 18)

__device__ __forceinline__ unsigned xb_ld(unsigned* p)              { return __hip_atomic_load(p, __ATOMIC_RELAXED, __HIP_MEMORY_SCOPE_AGENT); }
__device__ __forceinline__ unsigned xb_add(unsigned* p, unsigned v) { return __hip_atomic_fetch_add(p, v, __ATOMIC_RELAXED, __HIP_MEMORY_SCOPE_AGENT); }
__device__ __forceinline__ unsigned xb_xcc_id() { return (unsigned)__builtin_amdgcn_s_getreg((3 << 11) | 20) & 0xFu; }
#define XB_SPIN(cond, bar) do { unsigned _sp = 0; while (cond) { __builtin_amdgcn_s_sleep(1); \
    if ((++_sp & 255u) == 0u) { if (xb_ld(&(bar)[XB_TMO])) break; if (_sp > XB_SPIN_CAP) { atomicAdd(&(bar)[XB_TMO], 1u); break; } } } } while (0)

struct XcdBarrier {
    unsigned* bar; unsigned x;
    volatile LAS unsigned* st;
};

__device__ __forceinline__ XcdBarrier xcd_barrier_post(unsigned* bar, volatile LAS unsigned* st) {
    XcdBarrier b; b.bar = bar; b.x = xb_xcc_id(); b.st = st;
    if (threadIdx.x == 0) (void)xb_add(&bar[XB_XCNT(b.x)], 1u);
    return b;
}
__device__ __forceinline__ void xcd_barrier_complete(unsigned* bar, unsigned x, unsigned& nloc, unsigned& nx) {
    const unsigned G = gridDim.x * gridDim.y * gridDim.z;
    unsigned sum, cnt, mine, sp = 0u;
    for (;;) {
        sum = 0u; cnt = 0u; mine = 0u;
#pragma unroll
        for (unsigned j = 0; j < 16; ++j) { const unsigned c = xb_ld(&bar[XB_XCNT(j)]); sum += c; cnt += (c > 0u) ? 1u : 0u; mine = (j == x) ? c : mine; }
        if (sum == G) break;
        __builtin_amdgcn_s_sleep(1);
        if ((++sp & 255u) == 0u) { if (xb_ld(&bar[XB_TMO])) break; if (sp > XB_SPIN_CAP) { atomicAdd(&bar[XB_TMO], 1u); break; } }
    }
    nloc = mine > 0u ? mine : 1u; nx = cnt > 0u ? cnt : 1u;
}

__device__ __forceinline__ void xcd_barrier(const XcdBarrier& b) {
    asm volatile("s_waitcnt vmcnt(0)" ::: "memory");
    __syncthreads();
    if (threadIdx.x == 0) {
        unsigned* bar = b.bar;
        __builtin_amdgcn_s_waitcnt(0);
        unsigned nloc = b.st[0], nx = b.st[1];
        if (nloc == 0u) { xcd_barrier_complete(bar, b.x, nloc, nx); b.st[0] = nloc; b.st[1] = nx; }
        const unsigned old = xb_add(&bar[XB_XSUB(b.x)], 1u);
        const unsigned gen = old / nloc;
        if (old + 1u == (gen + 1u) * nloc) {
            __builtin_amdgcn_fence(__ATOMIC_RELEASE, "agent");
            asm volatile("s_waitcnt vmcnt(0)" ::: "memory");
            const unsigned og = xb_add(&bar[XB_TOP], 1u);
            const unsigned tg = og / nx;
            if (og + 1u == (tg + 1u) * nx) xb_add(&bar[XB_TOPGEN], 1u);
            else XB_SPIN(xb_ld(&bar[XB_TOPGEN]) == tg, bar);
            __builtin_amdgcn_fence(__ATOMIC_ACQUIRE, "agent");
            xb_add(&bar[XB_XGEN(b.x)], 1u);
            asm volatile("s_waitcnt vmcnt(0)" ::: "memory");
        } else {
            XB_SPIN(xb_ld(&bar[XB_XGEN(b.x)]) == gen, bar);
            __builtin_amdgcn_fence(__ATOMIC_ACQUIRE, "agent");
            asm volatile("s_waitcnt vmcnt(0)" ::: "memory");
        }
    }
    __syncthreads();
}
DI void rows_phase(Ctx& C, int l, int which) {
    const int gw = C.bid * NWV + C.wave, NGW = C.G * NWV; const float* MOD = WSP(float, WS_MOD);
#ifndef NO_ROWS
    if (which == 1) {
        for (int m = gw; m < MTOT; m += NGW) { const int cond = row_cond(m); const bool lat = m < MLAT; const float* modl = MOD + (size_t)cond * 6144;
            row_norm_mod(lat ? INP(0) + (size_t)m * DM : INP(2) + (size_t)(m - MLAT) * DM, INP(6), modl, modl + 1024, WSP(bf16, WS_XN) + (size_t)m * DM, C.lane); }
        return;
    }
    constexpr int NR = 4;
    LAS float* PV = (LAS float*)C.lds;
    {
        const bool nxt = (l + 1 < DEPTH); const int ln = (which == 2) ? l : (nxt ? l + 1 : l);
        f32x4 pvr[8];
#pragma unroll
        for (int i = 0; i < 8; ++i) { const int e0 = C.tid + NTHR * i, e = e0 < 3 * 5 * 256 ? e0 : 3 * 5 * 256 - 1; const int cond = e / 1280, v = (e / 256) % 5, c4 = (e & 255) * 4;
            const float* modl = MOD + (size_t)(l * 3 + cond) * 6144; const float* modn = MOD + (size_t)(ln * 3 + cond) * 6144; const float* src;
            if (which == 2) src = (v == 0) ? INP(7) + l * DM : (v == 1) ? modl + 2048 : (v == 2) ? INP(8) + l * DM : (v == 3) ? modl + 3072 : modl + 4096;
            else src = (v == 0) ? INP(9) + l * DM : (v == 1) ? modl + 5120 : (v == 2) ? INP(6) + ln * DM : (v == 3) ? modn : modn + 1024;
            pvr[i] = *(const f32x4*)(src + c4); }
#pragma unroll
        for (int i = 0; i < 8; ++i) { const int e = C.tid + NTHR * i; if (e < 3 * 5 * 256) *(LAS f32x4*)(PV + (e / 256) * 1024 + (e & 255) * 4) = pvr[i]; }
        __syncthreads();
    }
    const int Mr = (l == DEPTH - 1) ? MLAT : MTOT;
    for (int m0 = gw * NR; m0 < Mr; m0 += NGW * NR) {
        const int cond = row_cond(m0); const bool lat = m0 < MLAT; const LAS float* pv = PV + cond * 5 * 1024;
        const float* xi[NR]; const bf16* y[NR]; float* xo[NR]; bf16* xn[NR];
#pragma unroll
        for (int q = 0; q < NR; ++q) { const int m = m0 + q;
            float* xcur = lat ? C.out + (size_t)m * DM : WSP(float, WS_CX) + (size_t)(m - MLAT) * DM;
            const float* xorig = lat ? INP(0) + (size_t)m * DM : INP(2) + (size_t)(m - MLAT) * DM;
            xi[q] = (which == 2 && l == 0) ? xorig : xcur; xo[q] = xcur; xn[q] = WSP(bf16, WS_XN) + (size_t)m * DM;
            y[q] = (which == 2 ? WSP(bf16, WS_PX) : WSP(bf16, WS_MIX)) + (size_t)m * DM; }
        row_update<NR>(xi, y, pv, pv + 1024, xo, pv + 2048, pv + 3072, pv + 4096, xn, which == 2 || (l + 1 < DEPTH), C.lane);
    }
    __syncthreads();
#endif
}
DI void ft_phase(Ctx& C, int l) {
    for (int rep_ = 0; rep_ < (PROBE_FT ? 2 : 1); ++rep_)
    for (int it = C.bid; it < 256 + (l == 0 ? 4 : 0); it += C.G) {
        if (it < 256) ft_item(C, WSP(float, WS_H2) + (size_t)l * SEQ * 64, WSP(float, WS_W3T) + (size_t)l * 65536, WSP(float, WS_FT), SEQ, it * 64);
        else ft_item(C, WSP(float, WS_H2C), WSP(float, WS_W3T), WSP(float, WS_FTC), CTXL, (it - 256) * 64);
    }
}
template <int ACT> DI void gemm_run(Ctx& C, const bf16* A, const bf16* Bt, int M, int N, int K, bf16* O) {
    pg8::Gemm g{A, Bt, M, N, K}; pg8::StaticOrder S; S.init(M, N, C.G, C.bid);
    pg8::EpiBf16<ACT> E{O, N};
#ifndef NO_GEMM
    for (int rep_ = 0; rep_ < (PROBE_GEMM ? 2 : 1); ++rep_)
    pg8::gemm_phase<pg8::EpiBf16<ACT>, pg8::StaticOrder, true, true>((PG8_LAS unsigned char*)C.lds, g, S, E);
#endif
    __syncthreads();
}

#define GSYNC() do { xcd_barrier(bar); if (PROBE_SYNC) xcd_barrier(bar); } while (0)
#define RELAUNDER() do { int t_ = threadIdx.x; asm volatile("" : "+v"(t_)); C.tid = t_; C.lane = t_ & 63; } while (0)
__global__ void __launch_bounds__(NTHR, 2) fwd_megakernel(Args args) {
    extern __shared__ __attribute__((aligned(16))) unsigned char lds_raw[];
    cg::grid_group grid = cg::this_grid();
    Ctx C; C.in = args.in; C.out = args.out; C.ws = args.ws; C.lds = (LAS unsigned char*)lds_raw;
    C.tid = threadIdx.x; C.lane = C.tid & 63; C.wave = __builtin_amdgcn_readfirstlane(C.tid >> 6); C.G = gridDim.x; C.bid = blockIdx.x;
    volatile LAS unsigned* bst = (volatile LAS unsigned*)(C.lds + 131072 + 256);
    if (threadIdx.x < 2) bst[threadIdx.x] = 0u;
    __syncthreads();
    XcdBarrier bar = xcd_barrier_post((unsigned*)args.ws, bst);

#ifndef NO_P0
    phase0(C);
    if (PROBE_P0) { __syncthreads(); RELAUNDER(); phase0(C); }
#endif
    grid.sync(); RELAUNDER();
    rows_phase(C, 0, 1); RELAUNDER();
#ifndef NO_FT
    ft_phase(C, 0);
#endif
    GSYNC(); RELAUNDER();
    for (int l = 0; l < DEPTH; ++l) {
        gemm_run<0>(C, WSP(bf16, WS_XN), WSP(bf16, WS_WIN) + (size_t)l * INC * DM, MTOT, INC, DM, WSP(bf16, WS_PX));
        GSYNC(); RELAUNDER();
#ifndef NO_PREP
        for (int rep_ = 0; rep_ < (PROBE_PREP ? 2 : 1); ++rep_)
        for (int it = C.bid; it < NTILE64 * 9; it += C.G) {
            const int tt = it / 9, sub = it % 9; const Tile T = tile_of(tt);
            if (sub == 0) prep_qkv(C, l, T);
            else if (sub <= 3) prep_hyena(C, l, T, sub - 1);
            else if (sub == 4) prep_pool(C, l, T);
#ifndef NO_LRU
            else lru_item<1>(C, l, T, sub - 5);
#endif
        }
#endif
        GSYNC(); RELAUNDER();
        {
            lru_carry(C);
            const int nat = 256 + (l == 0 ? 8 : 0);
#ifndef NO_ATT
            for (int rep_ = 0; rep_ < (PROBE_ATT ? 2 : 1); ++rep_)
            for (int u = C.bid; u < nat; u += C.G) {
                if (u < 256) { const int b = u >> 7, h = (u >> 5) & 3, qt = u & 31, kvh = h >> 1;
                    attn_unit(C, WSP(bf16, WS_Q) + (size_t)(b * 4 + h) * SEQ * 64, WSP(bf16, WS_K) + (size_t)(b * 2 + kvh) * SKV * 64, WSP(bf16, WS_VT) + (size_t)(b * 2 + kvh) * 64 * SKV, SKV / 64,
                              WSP(bf16, WS_MIX) + (size_t)(b * SEQ) * DM + 256 + h * 64, qt * 512, 512); }
                else { const int uc = u - 256, b = uc >> 2, h = uc & 3, kvh = h >> 1;
                    attn_unit(C, WSP(bf16, WS_QC) + (size_t)(b * 4 + h) * CTXL * 64, WSP(bf16, WS_K) + (size_t)(b * 2 + kvh) * SKV * 64, WSP(bf16, WS_VT) + (size_t)(b * 2 + kvh) * 64 * SKV, CTXL / 64,
                              WSP(bf16, WS_MIX) + (size_t)(MLAT + b * CTXL) * DM + 256 + h * 64, 0, 256); }
            }
#endif
            RELAUNDER();
#ifndef NO_HY
#if PROBE_HY
            for (int c = C.bid; c < 256; c += C.G) hyena_unit(C, l, c, (f32x2v*)(C.ws + WS_XN) + (size_t)C.bid * 2 * SEQ, 1);
            RELAUNDER();
#endif
            for (int c = C.bid; c < 256; c += C.G) hyena_unit(C, l, c, (f32x2v*)(C.ws + WS_XN) + (size_t)C.bid * 2 * SEQ);
#endif
            RELAUNDER();
#ifndef NO_HYC
            if (l == 0) for (int c = C.bid; c < 256; c += C.G) hyena_ctx_unit(C, l, c);
#endif
        }
        GSYNC(); RELAUNDER();
#ifndef NO_TR
        for (int rep_ = 0; rep_ < (PROBE_TR ? 2 : 1); ++rep_)
        for (int tt = C.bid; tt < NTILE64; tt += C.G) ydt_transpose(C, tile_of(tt));
#endif
        RELAUNDER();
#ifndef NO_LRU
        for (int rep_ = 0; rep_ < (PROBE_TR ? 2 : 1); ++rep_)
        for (int it = C.bid; it < NTILE64 * 4; it += C.G) lru_item<2>(C, l, tile_of(it >> 2), it & 3);
#endif
        GSYNC(); RELAUNDER();
        const int Mg = (l == DEPTH - 1) ? MLAT : MTOT;
        gemm_run<0>(C, WSP(bf16, WS_MIX), WSP(bf16, WS_WOUT) + (size_t)l * DM * DM, Mg, DM, DM, WSP(bf16, WS_PX));
        GSYNC(); RELAUNDER();
        rows_phase(C, l, 2);
        if (PROBE_ROWS && l == 0) { RELAUNDER(); rows_phase(C, l, 2); }
        GSYNC(); RELAUNDER();
        gemm_run<2>(C, WSP(bf16, WS_XN), WSP(bf16, WS_W1) + (size_t)l * DFF * DM, Mg, DFF, DM, WSP(bf16, WS_PX));
        GSYNC(); RELAUNDER();
        gemm_run<0>(C, WSP(bf16, WS_PX), WSP(bf16, WS_W2) + (size_t)l * DM * DFF, Mg, DM, DFF, WSP(bf16, WS_MIX));
        GSYNC(); RELAUNDER();
        rows_phase(C, l, 3); RELAUNDER();
        if (l + 1 < DEPTH) {
#ifndef NO_FT
            ft_phase(C, l + 1);
#endif
            GSYNC(); RELAUNDER(); }
    }
}

extern "C" void kernel_launch(void* const* d_in, const int* in_sizes, int n_in, void* d_out, int out_size, void* d_ws, size_t ws_size, hipStream_t stream) {
    static int grid_blocks = 0;
    if (grid_blocks == 0) {
        if (n_in != 34 || ws_size < WS_END) { fprintf(stderr, "kernel_launch: unexpected n_in %d / ws %zu\n", n_in, ws_size); grid_blocks = -1; return; }
        int dev = 0, cus = 0, per_cu = 0;
        hipGetDevice(&dev); hipDeviceGetAttribute(&cus, hipDeviceAttributeMultiprocessorCount, dev);
        if (hipFuncSetAttribute((const void*)fwd_megakernel, hipFuncAttributeMaxDynamicSharedMemorySize, LDS_BYTES) != hipSuccess) { fprintf(stderr, "kernel_launch: hipFuncSetAttribute failed\n"); }
        if (hipOccupancyMaxActiveBlocksPerMultiprocessor(&per_cu, (const void*)fwd_megakernel, NTHR, LDS_BYTES) != hipSuccess || per_cu < 1) per_cu = 1;
        (void)hipGetLastError();
        grid_blocks = cus * per_cu; if (grid_blocks > 256) grid_blocks = 256;
    }
    if (grid_blocks < 0) return;
    Args a{};
    for (int i = 0; i < 34; ++i) a.in[i] = (const float*)d_in[i];
    a.out = (float*)d_out; a.ws = (unsigned char*)d_ws;
    void* kargs[] = {&a};
    if (hipMemsetAsync(d_ws, 0, 65536, stream) != hipSuccess) { fprintf(stderr, "kernel_launch: memset failed\n"); return; }
    hipError_t e = hipLaunchCooperativeKernel((const void*)fwd_megakernel, dim3(grid_blocks), dim3(NTHR), kargs, LDS_BYTES, stream);
    if (e != hipSuccess) fprintf(stderr, "cooperative launch failed: %s (grid %d)\n", hipGetErrorString(e), grid_blocks);
}
```

```cpp
#include <hip/hip_runtime.h>
#include <hip/hip_cooperative_groups.h>
#include <cstdio>
#include <cstdint>
namespace cg = cooperative_groups;
#ifndef PROBE_ATT
#define PROBE_ATT 0
#endif
#ifndef PROBE_GEMM
#define PROBE_GEMM 0
#endif
#ifndef PROBE_PREP
#define PROBE_PREP 0
#endif
#ifndef PROBE_HY
#define PROBE_HY 0
#endif
#ifndef PROBE_SYNC
#define PROBE_SYNC 0
#endif
#ifndef PROBE_P0
#define PROBE_P0 0
#endif
#ifndef PROBE_FT
#define PROBE_FT 0
#endif
#ifndef PROBE_TR
#define PROBE_TR 0
#endif
#ifndef PROBE_ROWS
#define PROBE_ROWS 0
#endif
namespace pg8 {
#define PG8_LAS __attribute__((address_space(3)))
typedef unsigned short bf16_t;
typedef short bf16x8 __attribute__((ext_vector_type(8)));
typedef float f32x4 __attribute__((ext_vector_type(4)));
typedef unsigned u32x4 __attribute__((ext_vector_type(4)));
constexpr int BM = 256, BK = 64, HALF = 128, HTB = HALF * BK * 2  , STAGE_BYTES = 8 * HTB, NXCD = 8, WGM = 8;

__host__ __device__ __forceinline__ int lds_byte(int r, int c) { const int st = (r >> 4) * 2 + (c >> 5), rr = r & 15, cc = c & 31, ob = rr * 64 + cc * 2; return st * 1024 + (ob ^ (((ob >> 9) & 1) << 5)); }
__host__ __device__ __forceinline__ void stage_rc(int b, int& R, int& C) { const int st = b / 1024, sb = b % 1024, swz = sb ^ (((sb >> 9) & 1) << 5); R = (st >> 1) * 16 + swz / 64; C = (st & 1) * 32 + (swz % 64) / 2; }
__host__ __device__ __forceinline__ int perm32(int rho) { const int n = rho >> 4, i = rho & 15; return 8 * (i >> 2) + 4 * n + (i & 3); }

struct Unit { int pm, pn; };
struct Gemm { const bf16_t* A; const bf16_t* Bt; int M, N, K; };

struct StaticOrder {
    int nM, nN, nwg, G, c;
    __host__ __device__ void init(int M, int N, int G_, int c_) { nM = M / BM; nN = N / BM; nwg = nM * nN; G = G_; c = c_; }
    __host__ __device__ bool next(int i, Unit& u) const {
        const long L = (long)i * G + c; if (L >= nwg) return false;
        int wgid = (int)L; { const int q = nwg / NXCD, r = nwg % NXCD, xcd = wgid % NXCD, off = wgid / NXCD; wgid = (xcd < r ? xcd * (q + 1) : r * (q + 1) + (xcd - r) * q) + off; }
        const int nig = WGM * nN, gid = wgid / nig, fm = gid * WGM, gsz = (nM - fm) < WGM ? (nM - fm) : WGM;
        u.pm = fm + ((wgid % nig) % gsz); u.pn = (wgid % nig) / gsz; return true;
    }
    __device__ __forceinline__ void a_ready(const Unit&) const {}
    __device__ __forceinline__ void done(const Unit&) const {}
};
__device__ __forceinline__ unsigned cvt_pk_bf16(float lo, float hi) { unsigned r; asm volatile("v_cvt_pk_bf16_f32 %0, %1, %2" : "=v"(r) : "v"(lo), "v"(hi)); return r; }
typedef float f32x2 __attribute__((ext_vector_type(2)));template <int ACT  > struct EpiBf16 {
    static constexpr bool PERM = true, AFTER_DRAIN = false;
    bf16_t* O; int ldc;
    __device__ __forceinline__ void operator()(const f32x4 (&acc)[2][2][4][2], const Unit& u, int wr, int wc, int fr, int fq) const {
        const int row0 = u.pm * BM + wr * 64 + fr; const int col0 = u.pn * BM + wc * 32 + 8 * fq;
#pragma unroll
        for (int ai = 0; ai < 2; ++ai)
#pragma unroll
            for (int m = 0; m < 4; ++m) { bf16_t* rowp = O + (size_t)(row0 + ai * HALF + m * 16) * ldc + col0;
#pragma unroll
                for (int bj = 0; bj < 2; ++bj) { f32x4 v0 = acc[ai][bj][m][0], v1 = acc[ai][bj][m][1];
                    if (ACT == 2) {
#pragma unroll
                        for (int e = 0; e < 4; ++e) { float a = v0[e] > 0.f ? v0[e] : 0.f; v0[e] = a * a; float b = v1[e] > 0.f ? v1[e] : 0.f; v1[e] = b * b; } }
                    u32x4 w; w.x = cvt_pk_bf16(v0[0], v0[1]); w.y = cvt_pk_bf16(v0[2], v0[3]); w.z = cvt_pk_bf16(v1[0], v1[1]); w.w = cvt_pk_bf16(v1[2], v1[3]);
                    *(u32x4*)(rowp + bj * HALF) = w; } }
    }
};
template <class Epi, class Sched, bool ALIGN_EPI = false, bool SP2 = false>
__device__ __forceinline__ void gemm_phase(PG8_LAS unsigned char* lds, const Gemm g, const Sched& S, const Epi& E) {
    int tid_ = threadIdx.x; asm volatile("" : "+v"(tid_)); const int tid = tid_, wid = __builtin_amdgcn_readfirstlane(tid >> 6), lane = tid & 63, wr = wid >> 2, wc = wid & 3, fr = lane & 15, fq = lane >> 4;
    const int K = g.K, nt = K / BK;
    unsigned voffA[2], voffB[2];
#pragma unroll
    for (int i = 0; i < 2; ++i) { int R, C; stage_rc(tid * 16 + i * 8192, R, C); const int Rb = Epi::PERM ? ((R & ~31) + perm32(R & 31)) : R;
        voffA[i] = (unsigned)(R * K + C) * 2u; voffB[i] = (unsigned)(Rb * K + C) * 2u; }
    const size_t kstep = (size_t)(BK * 2);
    const size_t hstep = (size_t)HALF * K * 2;
    const size_t tstep = 2 * hstep;
    const unsigned ldsw = (unsigned)wid * 1024u;
    const int aoff = lds_byte(wr * 64 + fr, fq * 8), boff = lds_byte(wc * 32 + fr, fq * 8);
#define PG8_SA(b, h) (((b) * 2 + (h)) * HTB)
#define PG8_SB(b, h) ((4 + (b) * 2 + (h)) * HTB)
#define PG8_STAGE(bufoff, gbase, voff) do { _Pragma("unroll") for (int _i = 0; _i < 2; ++_i) \
        __builtin_amdgcn_global_load_lds((const unsigned*)((const char*)(gbase) + (voff)[_i]), (PG8_LAS unsigned*)(lds + (bufoff) + ldsw + _i * 8192), 16, 0, 0); } while (0)
#define PG8_LDA(dst, b, h) do { _Pragma("unroll") for (int m = 0; m < 4; ++m) _Pragma("unroll") for (int k = 0; k < 2; ++k) dst[m][k] = *(const PG8_LAS bf16x8*)(lds + PG8_SA(b, h) + aoff + m * 2048 + k * 1024); } while (0)
#define PG8_LDB(dst, b, h) do { _Pragma("unroll") for (int n = 0; n < 2; ++n) _Pragma("unroll") for (int k = 0; k < 2; ++k) dst[n][k] = *(const PG8_LAS bf16x8*)(lds + PG8_SB(b, h) + boff + n * 2048 + k * 1024); } while (0)
#define PG8_MMA(ai, bj, At, Bt) do { __builtin_amdgcn_s_setprio(1); _Pragma("unroll") for (int m = 0; m < 4; ++m) _Pragma("unroll") for (int n = 0; n < 2; ++n) _Pragma("unroll") for (int k = 0; k < 2; ++k) \
        acc[ai][bj][m][n] = __builtin_amdgcn_mfma_f32_16x16x32_bf16(Bt[n][k], At[m][k], acc[ai][bj][m][n], 0, 0, 0); __builtin_amdgcn_s_setprio(0); } while (0)
#define PG8_WAIT_V(n) asm volatile("s_waitcnt vmcnt(" #n ")" ::: "memory")
#define PG8_WAIT_L(n) asm volatile("s_waitcnt lgkmcnt(" #n ")" ::: "memory")
#define PG8_BAR __builtin_amdgcn_s_barrier()
#define PG8_SCHED __builtin_amdgcn_sched_barrier(0)
    Unit cur, nxt; int ui = 0;
    if (!S.next(0, cur)) return;
    f32x4 acc[2][2][4][2];
#pragma unroll
    for (int a = 0; a < 2; ++a)
#pragma unroll
        for (int b = 0; b < 2; ++b)
#pragma unroll
            for (int m = 0; m < 4; ++m)
#pragma unroll
                for (int n = 0; n < 2; ++n) acc[a][b][m][n] = (f32x4){0.f, 0.f, 0.f, 0.f};
    bf16x8 At[4][2], B0[2][2], B1[2][2];
    const char* cA = (const char*)g.A + (size_t)cur.pm * tstep; const char* cB = (const char*)g.Bt + (size_t)cur.pn * tstep;
    S.a_ready(cur);
    if constexpr (SP2) {
        PG8_STAGE(PG8_SB(0, 0), cB, voffB); PG8_STAGE(PG8_SB(0, 1), cB + hstep, voffB); PG8_STAGE(PG8_SA(0, 0), cA, voffA); PG8_STAGE(PG8_SA(0, 1), cA + hstep, voffA);
        if (wr == 1) PG8_BAR;
        PG8_WAIT_V(2); PG8_BAR;
        PG8_STAGE(PG8_SB(1, 0), cB + kstep, voffB); PG8_STAGE(PG8_SA(1, 0), cA + kstep, voffA); PG8_STAGE(PG8_SB(1, 1), cB + hstep + kstep, voffB);
        PG8_WAIT_V(6); PG8_BAR;
    } else {
        PG8_STAGE(PG8_SB(0, 0), cB, voffB); PG8_STAGE(PG8_SA(0, 0), cA, voffA); PG8_STAGE(PG8_SB(0, 1), cB + hstep, voffB); PG8_STAGE(PG8_SA(0, 1), cA + hstep, voffA);
        if (wr == 1) PG8_BAR;
        PG8_WAIT_V(4); PG8_BAR;
        PG8_STAGE(PG8_SB(1, 0), cB + kstep, voffB); PG8_STAGE(PG8_SA(1, 0), cA + kstep, voffA); PG8_STAGE(PG8_SB(1, 1), cB + hstep + kstep, voffB);
        PG8_WAIT_V(6); PG8_BAR;
    }
    for (;;) {
        const bool has_next = S.next(ui + 1, nxt);
        const char* nA = has_next ? (const char*)g.A + (size_t)nxt.pm * tstep : cA; const char* nB = has_next ? (const char*)g.Bt + (size_t)nxt.pn * tstep : cB;
        for (int t = 0; t < nt; t += 2) {
            const bool last = (t == nt - 2);
            const char* a1 = cA + (size_t)(t + 1) * kstep;
            const char* a2 = last ? nA : cA + (size_t)(t + 2) * kstep; const char* b2 = last ? nB : cB + (size_t)(t + 2) * kstep;
            const char* a3 = a2 + kstep; const char* b3 = b2 + kstep;
            if (last && has_next) S.a_ready(nxt);
            if constexpr (SP2) {
            PG8_LDB(B0, 0, 0); PG8_LDB(B1, 0, 1); PG8_SCHED; PG8_LDA(At, 0, 0); PG8_STAGE(PG8_SA(1, 1), a1 + hstep, voffA);
            PG8_WAIT_V(8); PG8_WAIT_L(0); PG8_BAR; PG8_MMA(0, 0, At, B0); PG8_MMA(0, 1, At, B1); PG8_BAR; PG8_SCHED;
            PG8_LDA(At, 0, 1); PG8_STAGE(PG8_SB(0, 0), b2, voffB); PG8_STAGE(PG8_SB(0, 1), b2 + hstep, voffB); PG8_STAGE(PG8_SA(0, 0), a2, voffA);
            PG8_WAIT_V(8); PG8_WAIT_L(0); PG8_BAR; PG8_MMA(1, 0, At, B0); PG8_MMA(1, 1, At, B1); PG8_BAR; PG8_SCHED;
            PG8_LDB(B0, 1, 0); PG8_LDB(B1, 1, 1); PG8_SCHED; PG8_LDA(At, 1, 0); PG8_STAGE(PG8_SA(0, 1), a2 + hstep, voffA);
            PG8_WAIT_V(8); PG8_WAIT_L(0); PG8_BAR; PG8_MMA(0, 0, At, B0); PG8_MMA(0, 1, At, B1); PG8_BAR; PG8_SCHED;
            PG8_LDA(At, 1, 1); PG8_STAGE(PG8_SB(1, 0), b3, voffB); PG8_STAGE(PG8_SB(1, 1), b3 + hstep, voffB); PG8_STAGE(PG8_SA(1, 0), a3, voffA);
            PG8_WAIT_V(8); PG8_WAIT_L(0); PG8_BAR; PG8_MMA(1, 0, At, B0); PG8_MMA(1, 1, At, B1); PG8_BAR; PG8_SCHED;
            } else {
            PG8_LDB(B0, 0, 0); PG8_SCHED; PG8_LDA(At, 0, 0); PG8_STAGE(PG8_SA(1, 1), a1 + hstep, voffA);
            PG8_WAIT_L(8); PG8_BAR; PG8_WAIT_L(0); PG8_MMA(0, 0, At, B0); PG8_BAR; PG8_SCHED;
            PG8_LDB(B1, 0, 1); PG8_STAGE(PG8_SB(0, 0), b2, voffB);
            PG8_BAR; PG8_WAIT_L(0); PG8_MMA(0, 1, At, B1); PG8_BAR;
            PG8_LDA(At, 0, 1); PG8_STAGE(PG8_SA(0, 0), a2, voffA);
            PG8_BAR; PG8_WAIT_L(0); PG8_MMA(1, 0, At, B0); PG8_BAR; PG8_SCHED;
            PG8_STAGE(PG8_SB(0, 1), b2 + hstep, voffB);
            PG8_WAIT_V(6); PG8_BAR; PG8_MMA(1, 1, At, B1); PG8_BAR;
            PG8_LDB(B0, 1, 0); PG8_SCHED; PG8_LDA(At, 1, 0); PG8_STAGE(PG8_SA(0, 1), a2 + hstep, voffA);
            PG8_WAIT_L(8); PG8_BAR; PG8_WAIT_L(0); PG8_MMA(0, 0, At, B0); PG8_BAR; PG8_SCHED;
            PG8_LDB(B1, 1, 1); PG8_STAGE(PG8_SB(1, 0), b3, voffB);
            PG8_BAR; PG8_WAIT_L(0); PG8_MMA(0, 1, At, B1); PG8_BAR;
            PG8_LDA(At, 1, 1); PG8_STAGE(PG8_SA(1, 0), a3, voffA);
            PG8_BAR; PG8_WAIT_L(0); PG8_MMA(1, 0, At, B0); PG8_BAR; PG8_SCHED;
            PG8_STAGE(PG8_SB(1, 1), b3 + hstep, voffB);
            PG8_WAIT_V(6); PG8_BAR; PG8_MMA(1, 1, At, B1); PG8_BAR;
            }
        }
        if constexpr (ALIGN_EPI) { if (wr == 0) PG8_BAR; }
        if constexpr (!Epi::AFTER_DRAIN) { E(acc, cur, wr, wc, fr, fq); S.done(cur); }
        if (!has_next) break;
#pragma unroll
        for (int a = 0; a < 2; ++a)
#pragma unroll
            for (int b = 0; b < 2; ++b)
#pragma unroll
                for (int m = 0; m < 4; ++m)
#pragma unroll
                    for (int n = 0; n < 2; ++n) acc[a][b][m][n] = (f32x4){0.f, 0.f, 0.f, 0.f};
        cur = nxt; cA = nA; cB = nB; ++ui;
        if constexpr (ALIGN_EPI) { if (wr == 1) PG8_BAR; }
    }
    PG8_WAIT_V(0);
    if constexpr (!ALIGN_EPI) { if (wr == 0) PG8_BAR; }
    PG8_BAR;
    if constexpr (Epi::AFTER_DRAIN) { E.fused(acc, cur, wr, wc, fr, fq, lds, wid, lane); S.done(cur); }
#undef PG8_SA
#undef PG8_SB
#undef PG8_STAGE
#undef PG8_LDA
#undef PG8_LDB
#undef PG8_MMA
#undef PG8_WAIT_V
#undef PG8_WAIT_L
#undef PG8_BAR
#undef PG8_SCHED
}
}
#define DI __device__ __forceinline__
#define LAS __attribute__((address_space(3)))
typedef unsigned short bf16;
typedef float f32x2v __attribute__((ext_vector_type(2)));
typedef float f32x4 __attribute__((ext_vector_type(4)));
typedef float f32x16 __attribute__((ext_vector_type(16)));
typedef short bf16x8 __attribute__((ext_vector_type(8)));
typedef short s16x4 __attribute__((ext_vector_type(4)));
typedef unsigned u32x4 __attribute__((ext_vector_type(4)));
typedef unsigned u32x2 __attribute__((ext_vector_type(2)));

constexpr int NB = 2, SEQ = 16384, CTXL = 256, DM = 1024, DEPTH = 2, INC = 2048, DFF = 4096;
constexpr int MLAT = NB * SEQ, MCTX = NB * CTXL, MTOT = MLAT + MCTX;
constexpr int SKV = CTXL + SEQ;
constexpr int NTILE64 = MTOT / 64;
constexpr int NCHUNK = SKV / 64;
constexpr float EPSN = 1e-6f;
constexpr int NTHR = 512, NWV = 8;
constexpr int LDS_BYTES = 147456;

constexpr size_t MiB = 1u << 20;
constexpr size_t WS_MOD = 1 * MiB;
constexpr size_t WS_POOLWT = 1 * MiB + 256 * 1024;
constexpr size_t WS_LRUWT = 1 * MiB + 384 * 1024;
constexpr size_t WS_WIN = 2 * MiB, WS_WOUT = 10 * MiB, WS_W1 = 14 * MiB, WS_W2 = 30 * MiB;
constexpr size_t WS_AGG = 46 * MiB;
constexpr size_t WS_CX = 49 * MiB;
constexpr size_t WS_H2 = 51 * MiB;
constexpr size_t WS_H2C = 59 * MiB;
constexpr size_t WS_W3T = 59 * MiB + 256 * 1024;
constexpr size_t WS_FTC = 60 * MiB;
constexpr size_t WS_QC = 61 * MiB;
constexpr size_t WS_XN = 62 * MiB;
constexpr size_t WS_MIX = 127 * MiB;
constexpr size_t WS_PX = 192 * MiB;
constexpr size_t WS_ZT = 322 * MiB;
constexpr size_t WS_ZTC = 370 * MiB;
constexpr size_t WS_Q = 371 * MiB;
constexpr size_t WS_K = 387 * MiB;
constexpr size_t WS_VT = 396 * MiB;
constexpr size_t WS_YDT = 405 * MiB;
constexpr size_t WS_YDTC = 421 * MiB;
constexpr size_t WS_FT = 422 * MiB;
constexpr size_t WS_CARRY = 486 * MiB;
constexpr size_t WS_END = 488 * MiB;

struct Args { const float* in[34]; float* out; unsigned char* ws; };

DI unsigned f2bf(float f) { unsigned u = __builtin_bit_cast(unsigned, f); return (u + 0x7fffu + ((u >> 16) & 1u)) >> 16; }
DI unsigned pk2(float lo, float hi) { return f2bf(lo) | (f2bf(hi) << 16); }
DI float bf2f(unsigned h) { return __builtin_bit_cast(float, h << 16); }
DI float bflo(unsigned w) { return __builtin_bit_cast(float, w << 16); }
DI float bfhi(unsigned w) { return __builtin_bit_cast(float, w & 0xffff0000u); }
DI float wave_sum(float v) {
#pragma unroll
    for (int o = 1; o < 64; o <<= 1) v += __shfl_xor(v, o);
    return v;
}
DI float sigmoidf_(float x) { return __builtin_amdgcn_rcpf(1.f + __expf(-x)); }
DI float gelu_tanh(float x) { const float u = 0.7978845608028654f * (x + 0.044715f * x * x * x); return x * __builtin_amdgcn_rcpf(1.f + __expf(-2.0f * u)); }
DI void unpack8(const u32x4 w, float* f) { f[0] = bflo(w.x); f[1] = bfhi(w.x); f[2] = bflo(w.y); f[3] = bfhi(w.y); f[4] = bflo(w.z); f[5] = bfhi(w.z); f[6] = bflo(w.w); f[7] = bfhi(w.w); }

struct Ctx {
    const float* const* in; float* out; unsigned char* ws; LAS unsigned char* lds;
    int tid, lane, wave, G, bid;
};
#define WSP(T, off) ((T*)(C.ws + (off)))
#define INP(i) (C.in[i])

DI void transpose_item(const float* W, int K, int N, bf16* WT, LAS float* scr, int item, int lane) {
    const int nblk = N / 32, kb = item / nblk, nb = item % nblk, k0 = 64 * kb, n0 = 32 * nb;
#pragma unroll
    for (int i = 0; i < 32; ++i) { const int kk = 2 * i + (lane >> 5); scr[kk * 33 + (lane & 31)] = W[(size_t)(k0 + kk) * N + n0 + (lane & 31)]; }
    asm volatile("s_waitcnt lgkmcnt(0)" ::: "memory");
    const int c = lane & 7;
#pragma unroll
    for (int j = 0; j < 4; ++j) { const int n = (lane >> 3) + 8 * j; const LAS float* s = scr + (8 * c) * 33 + n;
        u32x4 o; o.x = pk2(s[0 * 33], s[1 * 33]); o.y = pk2(s[2 * 33], s[3 * 33]); o.z = pk2(s[4 * 33], s[5 * 33]); o.w = pk2(s[6 * 33], s[7 * 33]);
        *(u32x4*)(WT + (size_t)(n0 + n) * K + k0 + 8 * c) = o; }
    asm volatile("s_waitcnt lgkmcnt(0)" ::: "memory");
}

DI void h2_item(Ctx& C, int l, int Lf, int t0, float* outp) {
    LAS float* emb = (LAS float*)C.lds;
    LAS float* h1s = emb + 64 * 33;
    LAS float* w1s = h1s + 64 * 65;
    LAS float* w2s = w1s + 33 * 64;
    const float* w1 = INP(25) + l * 33 * 64; const float* b1 = INP(26) + l * 64; const float* fq = INP(27) + l * 64;
    const float* w2 = INP(28) + l * 64 * 64; const float* b2 = INP(29) + l * 64;
    const int tid = C.tid;
#pragma unroll
    for (int i = 0; i < 5; ++i) { const int e = tid + NTHR * i; const float v = w1[e < 33 * 64 ? e : 0]; if (e < 33 * 64) w1s[e] = v; }
#pragma unroll
    for (int i = 0; i < 8; ++i) { const int e = tid + NTHR * i; w2s[e] = w2[e]; }
    for (int e = tid; e < 64 * 33; e += NTHR) { const int t2 = e / 33, i = e % 33, t = t0 + t2; float v;
        if (i == 0) v = (float)t / (float)(Lf - 1);
        else { const int bi = (i - 1) & 15; const float band = 1e-4f + (float)bi * ((15.0f - 1e-4f) / 15.0f);
            const float wv = (6.283185307179586f * (float)t) / (float)Lf; const float z = wv * band; v = (i <= 16) ? __cosf(z) : -__sinf(z); }
        emb[e] = v; }
    __syncthreads();
    const int tp = tid & 63, jg = tid >> 6;
    float a[8];
#pragma unroll
    for (int q = 0; q < 8; ++q) a[q] = b1[jg * 8 + q];
#pragma unroll 11
    for (int i = 0; i < 33; ++i) { const float ev = emb[tp * 33 + i];
#pragma unroll
        for (int q = 0; q < 8; ++q) a[q] += ev * w1s[i * 64 + jg * 8 + q]; }
#pragma unroll
    for (int q = 0; q < 8; ++q) h1s[tp * 65 + jg * 8 + q] = __sinf(fq[jg * 8 + q] * a[q]);
    __syncthreads();
#pragma unroll
    for (int q = 0; q < 8; ++q) a[q] = b2[jg * 8 + q];
#pragma unroll 8
    for (int i = 0; i < 64; ++i) { const float hv = h1s[tp * 65 + i];
#pragma unroll
        for (int q = 0; q < 8; ++q) a[q] += hv * w2s[i * 64 + jg * 8 + q]; }
    float o[8];
#pragma unroll
    for (int q = 0; q < 8; ++q) o[q] = __sinf(fq[jg * 8 + q] * a[q]);
    float* dst = outp + (size_t)(t0 + tp) * 64 + jg * 8;
    *(f32x4*)dst = (f32x4){o[0], o[1], o[2], o[3]}; *(f32x4*)(dst + 4) = (f32x4){o[4], o[5], o[6], o[7]};
    __syncthreads();
}

DI void phase0(Ctx& C) {
    const int gw = C.bid * NWV + C.wave, NGW = C.G * NWV;
    {
        LAS float* scr = (LAS float*)(C.lds + C.wave * 16384);
        constexpr int I_IN = 16 * 64, I_OUT = 16 * 32, I_1 = 16 * 128, I_2 = 64 * 32, PER = I_IN + I_OUT + I_1 + I_2;
        for (int it = gw; it < 2 * PER; it += NGW) {
            const int l = it / PER; int r = it % PER;
            if (r < I_IN) { transpose_item(INP(10) + (size_t)l * DM * INC, DM, INC, WSP(bf16, WS_WIN) + (size_t)l * INC * DM, scr, r, C.lane); continue; } r -= I_IN;
            if (r < I_OUT) { transpose_item(INP(11) + (size_t)l * DM * DM, DM, DM, WSP(bf16, WS_WOUT) + (size_t)l * DM * DM, scr, r, C.lane); continue; } r -= I_OUT;
            if (r < I_1) { transpose_item(INP(32) + (size_t)l * DM * DFF, DM, DFF, WSP(bf16, WS_W1) + (size_t)l * DFF * DM, scr, r, C.lane); continue; } r -= I_1;
            transpose_item(INP(33) + (size_t)l * DFF * DM, DFF, DM, WSP(bf16, WS_W2) + (size_t)l * DM * DFF, scr, r, C.lane);
        }
    }
    {
        const int gt = C.bid * NTHR + C.tid, NGT = C.G * NTHR;
        for (int e = gt; e < 2 * 4 * 4096; e += NGT) { const int m = e >> 12, n = (e >> 6) & 63, k = e & 63; WSP(bf16, WS_POOLWT)[e] = (bf16)f2bf(INP(12)[m * 4096 + k * 64 + n]); }
        for (int e = gt; e < 2 * 2 * 2 * 4 * 4096; e += NGT) {
            const int k = e & 63, n = (e >> 6) & 63, blk = (e >> 12) & 3, which = (e >> 14) & 1, d = (e >> 15) & 1, l = e >> 16;
            const float* src = which ? INP(20) : INP(18);
            WSP(bf16, WS_LRUWT)[e] = (bf16)f2bf(src[(((l * 2 + d) * 4 + blk) * 64 + k) * 64 + n]); }
        for (int e = gt; e < 2 * 65536; e += NGT) { const int k = e & 63, col = (e >> 6) & 1023, l = e >> 16; WSP(float, WS_W3T)[e] = INP(30)[(l * 64 + k) * 1024 + col]; }
    }
    __syncthreads();
    {
        LAS float* sc = (LAS float*)C.lds;
        LAS float* red = sc + 3 * 1024;
        for (int e = C.tid; e < 3 * 1024; e += NTHR) { const int i = e >> 10, k = e & 1023; const float v = (i < 2) ? INP(1)[i * 1024 + k] : INP(3)[k]; sc[e] = v / (1.f + __expf(-v)); }
        __syncthreads();
        for (int it = C.bid; it < 192; it += C.G) {
            const int l = it / 96, j = (it % 96) * 64 + C.lane; const float* wm = INP(4) + (size_t)l * DM * 6144 + j;
            float a0 = 0.f, a1 = 0.f, a2 = 0.f; const int kb = C.wave * 128;
#pragma unroll 32
            for (int k = kb; k < kb + 128; ++k) { const float w = wm[(size_t)k * 6144]; a0 += sc[k] * w; a1 += sc[1024 + k] * w; a2 += sc[2048 + k] * w; }
            red[(C.wave * 3 + 0) * 64 + C.lane] = a0; red[(C.wave * 3 + 1) * 64 + C.lane] = a1; red[(C.wave * 3 + 2) * 64 + C.lane] = a2;
            __syncthreads();
            if (C.tid < 192) { const int i = C.tid >> 6, ln = C.tid & 63; float s = 0.f;
                for (int w = 0; w < 8; ++w) s += red[(w * 3 + i) * 64 + ln];
                const int jj = (it % 96) * 64 + ln; WSP(float, WS_MOD)[(l * 3 + i) * 6144 + jj] = s + INP(5)[l * 6144 + jj]; }
            __syncthreads();
        }
    }
    for (int it = C.bid; it < 2 * 256 + 4; it += C.G) {
        if (it < 512) { const int l = it >> 8; h2_item(C, l, SEQ, (it & 255) * 64, WSP(float, WS_H2) + (size_t)l * SEQ * 64); }
        else h2_item(C, 0, CTXL, (it - 512) * 64, WSP(float, WS_H2C));
    }
}

DI int row_cond(int m) { return m < MLAT ? (m >> 14) : 2; }
DI void row_norm_mod(const float* xr, const float* g, const float* shift, const float* scale, bf16* xn, int lane) {
    f32x4 v[4]; float s = 0.f;
#pragma unroll
    for (int j = 0; j < 4; ++j) { v[j] = *(const f32x4*)(xr + 4 * lane + 256 * j); s += (v[j].x * v[j].x + v[j].y * v[j].y) + (v[j].z * v[j].z + v[j].w * v[j].w); }
    const float r = rsqrtf(wave_sum(s) * (1.f / DM) + EPSN);
#pragma unroll
    for (int j = 0; j < 4; ++j) { const int c = 4 * lane + 256 * j; const f32x4 gg = *(const f32x4*)(g + c), sh = *(const f32x4*)(shift + c), sc = *(const f32x4*)(scale + c);
        f32x4 o; o = (v[j] * r * gg) * (sc + 1.0f) + sh;
        u32x2 w; w.x = pk2(o.x, o.y); w.y = pk2(o.z, o.w); *(u32x2*)(xn + c) = w; }
}
template <int NR> DI void row_update(const float* const (&xi)[NR], const bf16* const (&y)[NR], const LAS float* gpost, const LAS float* gate, float* const (&xo)[NR], const LAS float* gnext, const LAS float* shift, const LAS float* scale, bf16* const (&xn)[NR], bool donext, int lane) {
    f32x4 yv[NR][4], xv[NR][4]; float s[NR];
#pragma unroll
    for (int q = 0; q < NR; ++q) { s[q] = 0.f;
#pragma unroll
        for (int j = 0; j < 4; ++j) { const u32x2 w = *(const u32x2*)(y[q] + 4 * lane + 256 * j); yv[q][j] = (f32x4){bflo(w.x), bfhi(w.x), bflo(w.y), bfhi(w.y)}; xv[q][j] = *(const f32x4*)(xi[q] + 4 * lane + 256 * j);
            s[q] += (yv[q][j].x * yv[q][j].x + yv[q][j].y * yv[q][j].y) + (yv[q][j].z * yv[q][j].z + yv[q][j].w * yv[q][j].w); } }
    float s2[NR];
#pragma unroll
    for (int q = 0; q < NR; ++q) { const float r = rsqrtf(wave_sum(s[q]) * (1.f / DM) + EPSN); s2[q] = 0.f;
#pragma unroll
        for (int j = 0; j < 4; ++j) { const int c = 4 * lane + 256 * j; const f32x4 gp = *(const LAS f32x4*)(gpost + c), ga = *(const LAS f32x4*)(gate + c);
            xv[q][j] = xv[q][j] + ga * (yv[q][j] * r * gp); *(f32x4*)(xo[q] + c) = xv[q][j];
            s2[q] += (xv[q][j].x * xv[q][j].x + xv[q][j].y * xv[q][j].y) + (xv[q][j].z * xv[q][j].z + xv[q][j].w * xv[q][j].w); } }
    if (donext) {
#pragma unroll
        for (int q = 0; q < NR; ++q) { const float r2 = rsqrtf(wave_sum(s2[q]) * (1.f / DM) + EPSN);
#pragma unroll
            for (int j = 0; j < 4; ++j) { const int c = 4 * lane + 256 * j; const f32x4 gg = *(const LAS f32x4*)(gnext + c), sh = *(const LAS f32x4*)(shift + c), sc = *(const LAS f32x4*)(scale + c);
                const f32x4 o = (xv[q][j] * r2 * gg) * (sc + 1.0f) + sh; u32x2 w; w.x = pk2(o.x, o.y); w.y = pk2(o.z, o.w); *(u32x2*)(xn[q] + c) = w; } }
    }
}

DI void ft_item(Ctx& C, const float* H2, const float* W3T, float* FT, int Lf, int n0) {
    LAS float* wl = (LAS float*)C.lds;
    const int n = n0 + C.lane; float h[64];
#pragma unroll
    for (int i = 0; i < 16; ++i) { const f32x4 v = *(const f32x4*)(H2 + (size_t)n * 64 + 4 * i); h[4 * i] = v.x; h[4 * i + 1] = v.y; h[4 * i + 2] = v.z; h[4 * i + 3] = v.w; }
    const float t01 = (float)n / (float)(Lf - 1);
    const int wv = __builtin_amdgcn_readfirstlane(C.wave);
#pragma unroll 1
    for (int half = 0; half < 2; ++half) {
        __syncthreads();
#pragma unroll 16
        for (int e = C.tid; e < 512 * 16; e += NTHR) *(LAS f32x4*)(wl + 4 * e) = *(const f32x4*)(W3T + (size_t)half * 32768 + 4 * e);
        __syncthreads();
#pragma unroll 2
        for (int ci = 0; ci < 64; ++ci) {
            const int cl = wv * 64 + ci, col = half * 512 + cl; const LAS float* wc = wl + cl * 64; float a = 0.f;
#pragma unroll
            for (int k4 = 0; k4 < 16; ++k4) { const f32x4 w4 = *(const LAS f32x4*)(wc + 4 * k4); a += h[4 * k4] * w4.x; a += h[4 * k4 + 1] * w4.y; a += h[4 * k4 + 2] * w4.z; a += h[4 * k4 + 3] * w4.w; }
            const int c = col & 255, o = (col >> 8) & 1, dir = col >> 9;
            const float delta = 3.0701134573253944f + (float)c * ((15.350567286626972f - 3.0701134573253944f) / 255.0f);
            FT[(size_t)((o * 2 + dir) * 256 + c) * Lf + n] = a * __expf(-t01 * delta);
        }
    }
    __syncthreads();
}
struct Tile { int b, p0, Ls, m0, lat; };
DI Tile tile_of(int tt) { Tile t; if (tt < 512) { t.lat = 1; t.b = tt >> 8; t.p0 = (tt & 255) * 64; t.Ls = SEQ; t.m0 = t.b * SEQ + t.p0; } else { const int u = tt - 512; t.lat = 0; t.b = u >> 2; t.p0 = (u & 3) * 64; t.Ls = CTXL; t.m0 = MLAT + t.b * CTXL + t.p0; } return t; }

DI void head_norm_rope(const u32x4 (&raw)[4], const float* g, int a, int pos, bool rope, float oscale, bf16* dst) {
    float v[32];
#pragma unroll
    for (int i = 0; i < 4; ++i) unpack8(raw[i], v + 8 * i);
    float ss = 0.f;
#pragma unroll
    for (int i = 0; i < 32; ++i) ss += v[i] * v[i];
    ss += __shfl_xor(ss, 1);
    const float r = rsqrtf(ss * (1.f / 64.f) + EPSN);
#pragma unroll
    for (int i = 0; i < 32; ++i) v[i] = v[i] * r * g[a * 32 + i];
    if (rope) {
        const float coord = (float)(a == 0 ? (pos >> 6) : (pos & 63));
#pragma unroll
        for (int f = 0; f < 16; ++f) { const float inv = exp2f(-(float)f * (13.287712379549449f / 16.0f)); const float ang = coord * inv; const float sn = __sinf(ang), cs = __cosf(ang);
            const float t1 = v[f], t2 = v[16 + f]; v[f] = t1 * cs - t2 * sn; v[16 + f] = t2 * cs + t1 * sn; }
    }
#pragma unroll
    for (int i = 0; i < 4; ++i) { u32x4 w; w.x = pk2(v[8 * i] * oscale, v[8 * i + 1] * oscale); w.y = pk2(v[8 * i + 2] * oscale, v[8 * i + 3] * oscale); w.z = pk2(v[8 * i + 4] * oscale, v[8 * i + 5] * oscale); w.w = pk2(v[8 * i + 6] * oscale, v[8 * i + 7] * oscale);
        *(u32x4*)(dst + 8 * i) = w; }
}

DI void prep_qkv(Ctx& C, int l, const Tile& T) {
    const bf16* PX = WSP(bf16, WS_PX); int tid = C.tid; asm volatile("" : "+v"(tid));
    LAS bf16* vs = (LAS bf16*)C.lds;
    u32x4 qraw[4], xraw[4];
    {
        const int tok = tid >> 3, part = tid & 7, head = part >> 1, a = part & 1;
        const bf16* src = PX + (size_t)(T.m0 + tok) * INC + 256 + head * 64 + a * 32;
#pragma unroll
        for (int i = 0; i < 4; ++i) qraw[i] = *(const u32x4*)(src + 8 * i);
        const int ktok = tid >> 2, kpart = tid & 3, khead = kpart >> 1, ka = kpart & 1, u = tid - 256;
#pragma unroll
        for (int i = 0; i < 4; ++i) { const int e = u + 256 * i, vtok = e >> 4, vch = e & 15;
            const bf16* xs = (tid < 256) ? PX + (size_t)(T.m0 + ktok) * INC + 512 + khead * 64 + ka * 32 + 8 * i : PX + (size_t)(T.m0 + vtok) * INC + 640 + vch * 8;
            xraw[i] = *(const u32x4*)xs; }
    }
    {
        const int tok = tid >> 3, part = tid & 7, head = part >> 1, a = part & 1, pos = T.p0 + tok;
        bf16* dst = T.lat ? WSP(bf16, WS_Q) + ((size_t)(T.b * 4 + head) * SEQ + pos) * 64 + a * 32 : WSP(bf16, WS_QC) + ((size_t)(T.b * 4 + head) * CTXL + pos) * 64 + a * 32;
        head_norm_rope(qraw, INP(14) + l * 64, a, pos, T.lat != 0, 0.125f * 1.4426950408889634f, dst);
    }
    if (tid < 256) {
        const int tok = tid >> 2, part = tid & 3, head = part >> 1, a = part & 1, pos = T.p0 + tok;
        bf16* dst = WSP(bf16, WS_K) + ((size_t)(T.b * 2 + head) * SKV + (T.lat ? CTXL + pos : pos)) * 64 + a * 32;
        head_norm_rope(xraw, INP(15) + l * 64, a, pos, T.lat != 0, 1.0f, dst);
    } else {
        const int u = tid - 256;
#pragma unroll
        for (int i = 0; i < 4; ++i) { const int e = u + 256 * i, tok = e >> 4, ch = e & 15; *(LAS u32x4*)(vs + tok * 136 + ch * 8) = xraw[i]; }
    }
    __syncthreads();
#pragma unroll
    for (int i = 0; i < 2; ++i) { const int task = tid + 512 * i, d = task >> 3, chunk = task & 7; unsigned short e[8];
#pragma unroll
        for (int j = 0; j < 8; ++j) e[j] = vs[(chunk * 8 + j) * 136 + d];
        u32x4 w; w.x = e[0] | ((unsigned)e[1] << 16); w.y = e[2] | ((unsigned)e[3] << 16); w.z = e[4] | ((unsigned)e[5] << 16); w.w = e[6] | ((unsigned)e[7] << 16);
        const int kvh = d >> 6, dd = d & 63;
        *(u32x4*)(WSP(bf16, WS_VT) + ((size_t)(T.b * 2 + kvh) * 64 + dd) * SKV + (T.lat ? CTXL + T.p0 : T.p0) + chunk * 8) = w; }
    __syncthreads();
}

DI void prep_hyena(Ctx& C, int l, const Tile& T, int gsel) {
    const bf16* PX = WSP(bf16, WS_PX); int tid = C.tid; asm volatile("" : "+v"(tid));
    LAS bf16* ts = (LAS bf16*)C.lds;
    {
        u32x4 w[5];
#pragma unroll
        for (int i = 0; i < 5; ++i) { const int e0 = tid + 512 * i, e = e0 < 66 * 32 ? e0 : 66 * 32 - 1; const int r = e >> 5, ch = e & 31, p = T.p0 - 1 + r; const bool ok = (p >= 0 && p < T.Ls); const int pc = ok ? p : T.p0;
            w[i] = *(const u32x4*)(PX + (size_t)(T.m0 - T.p0 + pc) * INC + 1280 + gsel * 256 + ch * 8); if (!ok) w[i] = (u32x4){0u, 0u, 0u, 0u}; }
#pragma unroll
        for (int i = 0; i < 5; ++i) { const int e = tid + 512 * i; if (e < 66 * 32) *(LAS u32x4*)(ts + (e >> 5) * 264 + (e & 31) * 8) = w[i]; }
    }
    __syncthreads();
    const float* cw = INP(23) + l * 3 * 768; const float* cb = INP(24) + l * 768;
    const int col = tid & 255, ci = gsel * 256 + col;
    const float w0 = cw[ci], w1 = cw[768 + ci], w2 = cw[1536 + ci], bb = cb[ci];
#pragma unroll
    for (int i = 0; i < 4; ++i) { const int chunk = (tid >> 8) + 2 * i; float x[10];
#pragma unroll
        for (int j = 0; j < 10; ++j) x[j] = bf2f(ts[(chunk * 8 + j) * 264 + col]);
        float o[8];
#pragma unroll
        for (int j = 0; j < 8; ++j) o[j] = bb + w0 * x[j] + w1 * x[j + 1] + w2 * x[j + 2];
        u32x4 w; w.x = pk2(o[0], o[1]); w.y = pk2(o[2], o[3]); w.z = pk2(o[4], o[5]); w.w = pk2(o[6], o[7]);
        bf16* dst = T.lat ? WSP(bf16, WS_ZT) + ((size_t)(T.b * 768 + ci)) * SEQ + T.p0 + chunk * 8 : WSP(bf16, WS_ZTC) + ((size_t)(T.b * 768 + ci)) * CTXL + T.p0 + chunk * 8;
        *(u32x4*)dst = w; }
    __syncthreads();
}

DI void prep_pool(Ctx& C, int l, const Tile& T) {
    const bf16* PX = WSP(bf16, WS_PX); int tid = C.tid; asm volatile("" : "+v"(tid));
    LAS float* us = (LAS float*)C.lds;
    LAS bf16* dt = (LAS bf16*)(C.lds + 80 * 256 * 4);
    {
        u32x4 w[5];
#pragma unroll
        for (int i = 0; i < 5; ++i) { const int e = tid + 512 * i, r = e >> 5, ch = e & 31, p = T.p0 - 8 + r; const bool ok = (p >= 0 && p < T.Ls); const int pc = ok ? p : T.p0;
            w[i] = *(const u32x4*)(PX + (size_t)(T.m0 - T.p0 + pc) * INC + ch * 8); if (!ok) w[i] = (u32x4){0u, 0u, 0u, 0u}; }
#pragma unroll
        for (int i = 0; i < 5; ++i) { const int e = tid + 512 * i, r = e >> 5, ch = e & 31; float f[8]; unpack8(w[i], f);
#pragma unroll
            for (int j = 0; j < 8; ++j) us[r * 256 + ch * 8 + j] = f[j]; }
    }
    __syncthreads();
    {
        const int col = tid & 255, th = tid >> 8, g = col >> 6, half = 1 << g;
        const int j0 = th * 32; float s = 0.f;
        for (int q = j0 - half; q < j0 + half; ++q) s += us[(q + 8) * 256 + col];
#pragma unroll 4
        for (int j = j0; j < j0 + 32; ++j) {
            const int p = T.p0 + j; int lo = p - half; if (lo < 0) lo = 0; int hi = p + half; if (hi > T.Ls) hi = T.Ls;
            const float d = s * __builtin_amdgcn_rcpf((float)(hi - lo)) - us[(j + 8) * 256 + col];
            dt[j * 264 + col] = (bf16)f2bf(d);
            s += us[(j + half + 8) * 256 + col] - us[(j - half + 8) * 256 + col];
        }
    }
    __syncthreads();
    {
        const int w = C.wave, g = w >> 1, th = w & 1, lane = tid & 63, rr = lane & 15, quad = lane >> 4;
        const bf16* WT = WSP(bf16, WS_POOLWT) + (size_t)(l * 4 + g) * 4096;
        bf16x8 af[2][2];
#pragma unroll
        for (int mt = 0; mt < 2; ++mt)
#pragma unroll
            for (int ks = 0; ks < 2; ++ks) af[mt][ks] = *(const LAS bf16x8*)(dt + (th * 32 + mt * 16 + rr) * 264 + g * 64 + ks * 32 + quad * 8);
        bf16x8 bfr[4][2]; float psc[4];
#pragma unroll
        for (int nt = 0; nt < 4; ++nt) {
#pragma unroll
            for (int ks = 0; ks < 2; ++ks) bfr[nt][ks] = *(const bf16x8*)(WT + (nt * 16 + rr) * 64 + ks * 32 + quad * 8);
            psc[nt] = INP(13)[l * 256 + g * 64 + nt * 16 + rr]; }
#pragma unroll
        for (int nt = 0; nt < 4; ++nt) {
            const int oc = g * 64 + nt * 16 + rr;
#pragma unroll
            for (int mt = 0; mt < 2; ++mt) { f32x4 acc = (f32x4){0.f, 0.f, 0.f, 0.f};
#pragma unroll
                for (int ks = 0; ks < 2; ++ks) acc = __builtin_amdgcn_mfma_f32_16x16x32_bf16(af[mt][ks], bfr[nt][ks], acc, 0, 0, 0);
#pragma unroll
                for (int j = 0; j < 4; ++j) { const int tok = th * 32 + mt * 16 + quad * 4 + j; WSP(bf16, WS_MIX)[(size_t)(T.m0 + tok) * DM + oc] = (bf16)f2bf(acc[j] * psc[nt]); } }
        }
    }
    __syncthreads();
}

template <int PH> DI void lru_item(Ctx& C, int l, const Tile& T, int nb) {
    const bf16* PX = WSP(bf16, WS_PX); int tid = C.tid; asm volatile("" : "+v"(tid)); const int lane = tid & 63;
    LAS float* xcf = (LAS float*)C.lds;
    LAS bf16* xcb = (LAS bf16*)(C.lds + 64 * 65 * 4);
    LAS float* as_ = (LAS float*)(C.lds + 32768);
    LAS float* bs_ = as_ + 2 * 64 * 64;
    {
        const int tok = tid >> 3, c8 = tid & 7, p = T.p0 + tok, ch0 = nb * 64 + c8 * 8; float acc[8];
        const float* cw = INP(16) + l * 4 * 256; const float* cb = INP(17) + l * 256;
#pragma unroll
        for (int j = 0; j < 8; ++j) acc[j] = cb[ch0 + j];
#pragma unroll
        for (int k = 0; k < 4; ++k) { const int q = p + k - 2;
            if (q >= 0 && q < T.Ls) { float f[8]; unpack8(*(const u32x4*)(PX + (size_t)(T.m0 - T.p0 + q) * INC + 768 + ch0), f);
#pragma unroll
                for (int j = 0; j < 8; ++j) acc[j] += cw[k * 256 + ch0 + j] * f[j]; } }
#pragma unroll
        for (int j = 0; j < 8; ++j) xcf[tok * 65 + c8 * 8 + j] = acc[j];
        u32x4 w; w.x = pk2(acc[0], acc[1]); w.y = pk2(acc[2], acc[3]); w.z = pk2(acc[4], acc[5]); w.w = pk2(acc[6], acc[7]);
        *(LAS u32x4*)(xcb + tok * 72 + c8 * 8) = w;
    }
    __syncthreads();
    {
        const int w = C.wave, dir = w >> 2, tq = w & 3, rr = lane & 15, quad = lane >> 4;
        bf16x8 af[2];
#pragma unroll
        for (int ks = 0; ks < 2; ++ks) af[ks] = *(const LAS bf16x8*)(xcb + (tq * 16 + rr) * 72 + ks * 32 + quad * 8);
        const bf16* WA = WSP(bf16, WS_LRUWT) + (size_t)((((l * 2 + dir) * 2 + 0) * 4 + nb)) * 4096;
        const bf16* WX = WSP(bf16, WS_LRUWT) + (size_t)((((l * 2 + dir) * 2 + 1) * 4 + nb)) * 4096;
#pragma unroll
        for (int nt = 0; nt < 4; ++nt) {
            f32x4 ar = (f32x4){0.f, 0.f, 0.f, 0.f}, ai = (f32x4){0.f, 0.f, 0.f, 0.f};
#pragma unroll
            for (int ks = 0; ks < 2; ++ks) { const bf16x8 ba = *(const bf16x8*)(WA + (nt * 16 + rr) * 64 + ks * 32 + quad * 8), bx = *(const bf16x8*)(WX + (nt * 16 + rr) * 64 + ks * 32 + quad * 8);
                ar = __builtin_amdgcn_mfma_f32_16x16x32_bf16(af[ks], ba, ar, 0, 0, 0); ai = __builtin_amdgcn_mfma_f32_16x16x32_bf16(af[ks], bx, ai, 0, 0, 0); }
            const int chl = nt * 16 + rr, ch = nb * 64 + chl; const int pi = (l * 2 + dir) * 256 + ch;
            const float br = INP(19)[pi], bi = INP(21)[pi], lam = INP(22)[pi]; const float sp = log1pf(__expf(-lam));
#pragma unroll
            for (int j = 0; j < 4; ++j) { const int tok = tq * 16 + quad * 4 + j;
                const float r = sigmoidf_(ar[j] + br), ig = sigmoidf_(ai[j] + bi); const float la = -8.0f * r * sp; const float a = __expf(la);
                const float bcoef = __builtin_amdgcn_sqrtf(fmaxf(-expm1f(2.0f * la), 0.f)) * (ig * xcf[tok * 65 + chl]);
                as_[(dir * 64 + tok) * 64 + chl] = a; bs_[(dir * 64 + tok) * 64 + chl] = bcoef; }
        }
    }
    __syncthreads();
    const int cid = T.lat ? 4 + (T.p0 >> 6) : (T.p0 >> 6);
    float* AGG = WSP(float, WS_AGG);
    if (tid < 128) {
        const int dir = tid >> 6, chl = tid & 63, ch = nb * 64 + chl; float h = 0.f;
        if (PH == 2) h = WSP(float, WS_CARRY)[(size_t)(T.b * NCHUNK + cid) * 512 + dir * 256 + ch];
        float A = 1.f;
        if (dir == 0) {
#pragma unroll 16
            for (int t = 0; t < 64; ++t) { const float a = as_[(dir * 64 + t) * 64 + chl], b = bs_[(dir * 64 + t) * 64 + chl]; h = a * h + b; A *= a; if (PH == 2) bs_[(dir * 64 + t) * 64 + chl] = h; } }
        else {
#pragma unroll 16
            for (int t = 63; t >= 0; --t) { const float a = as_[(dir * 64 + t) * 64 + chl], b = bs_[(dir * 64 + t) * 64 + chl]; h = a * h + b; A *= a; if (PH == 2) bs_[(dir * 64 + t) * 64 + chl] = h; } }
        if (PH == 1) { float* ag = AGG + ((size_t)(T.b * NCHUNK + cid) * 2 + dir) * 512 + ch; ag[0] = A; ag[256] = h; }
    }
    __syncthreads();
    if (PH == 2) {
        const int tok = tid >> 3, c8 = tid & 7, ch0 = nb * 64 + c8 * 8; float g[8], o[8];
        unpack8(*(const u32x4*)(PX + (size_t)(T.m0 + tok) * INC + 1024 + ch0), g);
#pragma unroll
        for (int j = 0; j < 8; ++j) o[j] = (bs_[tok * 64 + c8 * 8 + j] + bs_[(64 + tok) * 64 + c8 * 8 + j]) * gelu_tanh(g[j]);
        u32x4 w; w.x = pk2(o[0], o[1]); w.y = pk2(o[2], o[3]); w.z = pk2(o[4], o[5]); w.w = pk2(o[6], o[7]);
        *(u32x4*)(WSP(bf16, WS_MIX) + (size_t)(T.m0 + tok) * DM + 512 + ch0) = w;
        __syncthreads();
    }
}

DI void lru_carry(Ctx& C) {
    if (C.bid >= 16) return;
    const int b = C.bid >> 3, dir = (C.bid >> 2) & 1, ch = (C.bid & 3) * 64 + C.lane, w = C.wave;
    const float* ag = WSP(float, WS_AGG) + (size_t)b * NCHUNK * 1024 + dir * 512 + ch;
    float* cr = WSP(float, WS_CARRY) + (size_t)b * NCHUNK * 512 + dir * 256 + ch;
    LAS float* sa = (LAS float*)C.lds; LAS float* sb = sa + 8 * 64;
    constexpr int SEG = 33;
    const int s0 = w * SEG; float a[SEG], bq[SEG];
#pragma unroll
    for (int i = 0; i < SEG; ++i) { const int s = s0 + i; const int cid = dir == 0 ? s : (s < 4 ? 3 - s : NCHUNK + 3 - s);
        if (s < NCHUNK) { a[i] = ag[(size_t)cid * 1024]; bq[i] = ag[(size_t)cid * 1024 + 256]; } else { a[i] = 1.f; bq[i] = 0.f; } }
    float A = 1.f, B = 0.f;
#pragma unroll
    for (int i = 0; i < SEG; ++i) { B = a[i] * B + bq[i]; A *= a[i]; }
    sa[w * 64 + C.lane] = A; sb[w * 64 + C.lane] = B;
    __syncthreads();
    float h = 0.f;
    for (int w2 = 0; w2 < w; ++w2) h = sa[w2 * 64 + C.lane] * h + sb[w2 * 64 + C.lane];
#pragma unroll
    for (int i = 0; i < SEG; ++i) { const int s = s0 + i; const int cid = dir == 0 ? s : (s < 4 ? 3 - s : NCHUNK + 3 - s);
        if (s < NCHUNK) { cr[(size_t)cid * 512] = h; h = a[i] * h + bq[i]; } }
    __syncthreads();
}
DI float max3f(float a, float b, float c) { float r; asm("v_max3_f32 %0, %1, %2, %3" : "=v"(r) : "v"(a), "v"(b), "v"(c)); return r; }
DI int crow(int r, int hi) { return (r & 3) + 8 * (r >> 2) + 4 * hi; }
DI unsigned cvtpk(float lo, float hi) { typedef __bf16 bf16x2_t __attribute__((ext_vector_type(2))); f32x2v v = {lo, hi}; bf16x2_t b = __builtin_convertvector(v, bf16x2_t); return __builtin_bit_cast(unsigned, b); }
DI void attn_unit(Ctx& C, const bf16* Qp, const bf16* Kp, const bf16* VTp, int NT, bf16* Op, int q0, int nrows) {
    int tid = C.tid; asm volatile("" : "+v"(tid)); const int lane = tid & 63, w = C.wave, r = lane & 31, hi = lane >> 5;
    LAS unsigned char* Ks = C.lds;
    LAS unsigned char* Vs = C.lds + 2 * 9216;
    LAS float* wsf = (LAS float*)(C.lds + 4 * 9216) + w * 64;
    bf16x8 qf[2][4];
#pragma unroll
    for (int g = 0; g < 2; ++g)
#pragma unroll
        for (int d0 = 0; d0 < 4; ++d0) qf[g][d0] = *(const bf16x8*)(Qp + (size_t)(q0 + w * 64 + g * 32 + r) * 64 + d0 * 16 + hi * 8);
    const int srow = tid >> 3, sch = tid & 7;
    u32x4 kreg = *(const u32x4*)(Kp + (size_t)tid * 8);
    u32x4 vreg = *(const u32x4*)(VTp + (size_t)srow * SKV + sch * 8);
    *(LAS u32x4*)(Ks + srow * 144 + sch * 16) = kreg; *(LAS u32x4*)(Vs + srow * 144 + sch * 16) = vreg;
    __syncthreads();
    f32x16 o[2][2];
#pragma unroll
    for (int g = 0; g < 2; ++g)
#pragma unroll
        for (int i = 0; i < 16; ++i) { o[g][0][i] = 0.f; o[g][1][i] = 0.f; }
    float m[2] = {0.f, 0.f}, lsum[2] = {0.f, 0.f};
    bool anym = false;
    for (int t = 0; t < NT; ++t) {
        const int cur = t & 1; const bool more = (t + 1 < NT);
        if (more) { kreg = *(const u32x4*)(Kp + (size_t)(t + 1) * 4096 + (size_t)tid * 8); vreg = *(const u32x4*)(VTp + (size_t)srow * SKV + (t + 1) * 64 + sch * 8); }
        const LAS unsigned char* kb = Ks + cur * 9216 + r * 144 + hi * 16;
        const LAS unsigned char* vb = Vs + cur * 9216 + r * 144 + hi * 8;
        f32x16 p[2][2]; u32x4 pa[2][2][2]; bf16x8 kf[2][4];
        const f32x16 z = {0.f, 0.f, 0.f, 0.f, 0.f, 0.f, 0.f, 0.f, 0.f, 0.f, 0.f, 0.f, 0.f, 0.f, 0.f, 0.f};
#pragma unroll
        for (int d0 = 0; d0 < 4; ++d0) { kf[0][d0] = *(const LAS bf16x8*)(kb + d0 * 32); kf[1][d0] = *(const LAS bf16x8*)(kb + 32 * 144 + d0 * 32); }
#define ATT_QK(g) do { _Pragma("unroll") for (int d0 = 0; d0 < 4; ++d0) { \
            p[g][0] = __builtin_amdgcn_mfma_f32_32x32x16_bf16(kf[0][d0], qf[g][d0], d0 == 0 ? z : p[g][0], 0, 0, 0); \
            p[g][1] = __builtin_amdgcn_mfma_f32_32x32x16_bf16(kf[1][d0], qf[g][d0], d0 == 0 ? z : p[g][1], 0, 0, 0); } } while (0)
#define MX3(a, b, c) fmaxf(fmaxf((a), (b)), (c))
#define ATT_MAX(g) do { float mx = MX3(p[g][0][0], p[g][1][0], p[g][0][1]), mx2 = MX3(p[g][1][1], p[g][0][2], p[g][1][2]); \
            _Pragma("unroll") for (int i = 3; i < 15; i += 2) { mx = MX3(mx, p[g][0][i], p[g][1][i]); mx2 = MX3(mx2, p[g][0][i + 1], p[g][1][i + 1]); } \
            mx = MX3(mx, p[g][0][15], p[g][1][15]); mx = fmaxf(mx, mx2); \
            mx = fmaxf(mx, __shfl_xor(mx, 32)); \
            if (__builtin_expect(__any(mx > m[g] + 16.0f), 0)) {      \
                const float dl = fmaxf(mx - m[g], 0.f); m[g] += dl; const float alpha = __builtin_amdgcn_exp2f(-dl); lsum[g] *= alpha; anym = true; \
                if (hi == 0) wsf[g * 32 + r] = alpha; \
                _Pragma("unroll") for (int i = 0; i < 16; ++i) { const float f = wsf[g * 32 + crow(i, hi)]; o[g][0][i] *= f; o[g][1][i] *= f; } } \
            if (__builtin_expect(anym, 0)) { const float mg = m[g];         \
                _Pragma("unroll") for (int i = 0; i < 16; ++i) { p[g][0][i] -= mg; p[g][1][i] -= mg; } } } while (0)
#define ATT_EXP(g) do { float ps = 0.f; \
            _Pragma("unroll") for (int i = 0; i < 16; ++i) { p[g][0][i] = __builtin_amdgcn_exp2f(p[g][0][i]); p[g][1][i] = __builtin_amdgcn_exp2f(p[g][1][i]); ps += p[g][0][i] + p[g][1][i]; } \
            lsum[g] += ps; \
            _Pragma("unroll") for (int kbk = 0; kbk < 2; ++kbk) _Pragma("unroll") for (int s = 0; s < 2; ++s) \
                pa[g][kbk][s] = (u32x4){cvtpk(p[g][kbk][8 * s], p[g][kbk][8 * s + 1]), cvtpk(p[g][kbk][8 * s + 2], p[g][kbk][8 * s + 3]), cvtpk(p[g][kbk][8 * s + 4], p[g][kbk][8 * s + 5]), cvtpk(p[g][kbk][8 * s + 6], p[g][kbk][8 * s + 7])}; } while (0)
#define ATT_PV(g) do { _Pragma("unroll") for (int kbk = 0; kbk < 2; ++kbk) _Pragma("unroll") for (int s = 0; s < 2; ++s) _Pragma("unroll") for (int db = 0; db < 2; ++db) \
            o[g][db] = __builtin_amdgcn_mfma_f32_32x32x16_bf16(__builtin_bit_cast(bf16x8, pa[g][kbk][s]), vf[kbk][s][db], o[g][db], 0, 0, 0); } while (0)
#define ATT_MIX(nv) do { _Pragma("unroll") for (int q_ = 0; q_ < 8; ++q_) { __builtin_amdgcn_sched_group_barrier(0x008, 1, 0); __builtin_amdgcn_sched_group_barrier(0x400, 4, 0); __builtin_amdgcn_sched_group_barrier(0x002, nv, 0); } } while (0)
        ATT_QK(0); ATT_MAX(0);
        asm volatile("" : "+v"(kf[0][0]), "+v"(kf[1][0]));
        ATT_QK(1); ATT_EXP(0); ATT_MIX(6);
        asm volatile("" : "+v"(pa[0][0][0]), "+v"(pa[0][0][1]), "+v"(pa[0][1][0]), "+v"(pa[0][1][1]), "+v"(lsum[0]));
        ATT_MAX(1);
        bf16x8 vf[2][2][2];
#pragma unroll
        for (int kbk = 0; kbk < 2; ++kbk)
#pragma unroll
            for (int s = 0; s < 2; ++s)
#pragma unroll
                for (int db = 0; db < 2; ++db) {
                    const s16x4 lo = *(const LAS s16x4*)(vb + db * 32 * 144 + (kbk * 32 + s * 16) * 2), hh = *(const LAS s16x4*)(vb + db * 32 * 144 + (kbk * 32 + s * 16 + 8) * 2);
                    vf[kbk][s][db] = (bf16x8){lo[0], lo[1], lo[2], lo[3], hh[0], hh[1], hh[2], hh[3]}; }
        ATT_PV(0); ATT_EXP(1); ATT_MIX(6);
        asm volatile("" : "+v"(pa[1][0][0]), "+v"(pa[1][0][1]), "+v"(pa[1][1][0]), "+v"(pa[1][1][1]), "+v"(lsum[1]));
        ATT_PV(1);
#undef ATT_QK
#undef ATT_MAX
#undef MX3
#undef ATT_EXP
#undef ATT_PV
#undef ATT_MIX
        if (more) { *(LAS u32x4*)(Ks + (cur ^ 1) * 9216 + srow * 144 + sch * 16) = kreg; *(LAS u32x4*)(Vs + (cur ^ 1) * 9216 + srow * 144 + sch * 16) = vreg; }
        __syncthreads();
    }
    const bool active = (w * 64 < nrows);
#pragma unroll
    for (int g = 0; g < 2; ++g) {
        float l = lsum[g]; l += __shfl_xor(l, 32);
        if (hi == 0) wsf[g * 32 + r] = 1.f / l;
        if (active) {
#pragma unroll
            for (int i = 0; i < 16; ++i) { const int q = crow(i, hi); const float f = wsf[g * 32 + q]; bf16* orow = Op + (size_t)(q0 + w * 64 + g * 32 + q) * DM;
                orow[r] = (bf16)f2bf(o[g][0][i] * f); orow[32 + r] = (bf16)f2bf(o[g][1][i] * f); }
        }
    }
    __syncthreads();
}

DI f32x2v cmul(f32x2v a, f32x2v b) { return (f32x2v){a.x * b.x - a.y * b.y, a.x * b.y + a.y * b.x}; }
DI int swz(int i) { return i ^ (((i >> 6) & 7) << 2); }
DI f32x2v cmulc(f32x2v a, f32x2v b) { return (f32x2v){a.x * b.x + a.y * b.y, a.y * b.x - a.x * b.y}; }
DI void bfly4f(f32x2v& a0, f32x2v& a1, f32x2v& a2, f32x2v& a3) {
    const f32x2v t0 = a0 + a2, t1 = a0 - a2, t2 = a1 + a3, d = a1 - a3; const f32x2v t3 = (f32x2v){d.y, -d.x};
    a0 = t0 + t2; a1 = t1 + t3; a2 = t0 - t2; a3 = t1 - t3;
}
DI void bfly4i(f32x2v& a0, f32x2v& a1, f32x2v& a2, f32x2v& a3) {
    const f32x2v s0 = a0 + a2, s1 = a0 - a2, s2 = a1 + a3, d = a1 - a3; const f32x2v s3 = (f32x2v){-d.y, d.x};
    a0 = s0 + s2; a1 = s1 + s3; a2 = s0 - s2; a3 = s1 - s3;
}
template <int T, bool INV> DI void fft_pass16(LAS f32x2v* buf, int tid) {
    asm volatile("" : "+v"(tid));
    constexpr float C1 = 0.9238795325112867f, S1 = 0.3826834323650898f, C2 = 0.7071067811865476f;
#pragma unroll 1
    for (int it = 0; it < 2; ++it) {
        const int j = tid + 512 * it, pos = j & (T - 1), base = ((j - pos) << 4) + pos;
        f32x2v e[16];
#pragma unroll
        for (int m = 0; m < 16; ++m) e[m] = buf[swz(base + m * T)];
        const float fr = (float)pos / (float)(16 * T);
        const f32x2v wp = (f32x2v){__builtin_amdgcn_cosf(fr), -__builtin_amdgcn_sinf(fr)};
        const f32x2v wp2 = cmul(wp, wp), wp4 = cmul(wp2, wp2);
        const f32x2v wp8 = cmul(wp4, wp4), wp12 = cmul(wp8, wp4);
        if (!INV) {
#pragma unroll
            for (int m = 0; m < 4; ++m) {
                const f32x2v c16 = (m == 0) ? (f32x2v){1.f, 0.f} : (m == 1) ? (f32x2v){C1, -S1} : (m == 2) ? (f32x2v){C2, -C2} : (f32x2v){S1, -C1};
                const f32x2v w1 = cmul(wp, c16), w2 = cmul(w1, w1), w3 = cmul(w2, w1);
                bfly4f(e[m], e[m + 4], e[m + 8], e[m + 12]);
                e[m + 4] = cmul(e[m + 4], w1); e[m + 8] = cmul(e[m + 8], w2); e[m + 12] = cmul(e[m + 12], w3);
            }
#pragma unroll
            for (int q = 0; q < 4; ++q) {
                bfly4f(e[4 * q], e[4 * q + 1], e[4 * q + 2], e[4 * q + 3]);
                e[4 * q + 1] = cmul(e[4 * q + 1], wp4); e[4 * q + 2] = cmul(e[4 * q + 2], wp8); e[4 * q + 3] = cmul(e[4 * q + 3], wp12);
            }
        } else {
#pragma unroll
            for (int q = 0; q < 4; ++q) {
                e[4 * q + 1] = cmulc(e[4 * q + 1], wp4); e[4 * q + 2] = cmulc(e[4 * q + 2], wp8); e[4 * q + 3] = cmulc(e[4 * q + 3], wp12);
                bfly4i(e[4 * q], e[4 * q + 1], e[4 * q + 2], e[4 * q + 3]);
            }
#pragma unroll
            for (int m = 0; m < 4; ++m) {
                const f32x2v c16 = (m == 0) ? (f32x2v){1.f, 0.f} : (m == 1) ? (f32x2v){C1, -S1} : (m == 2) ? (f32x2v){C2, -C2} : (f32x2v){S1, -C1};
                const f32x2v w1 = cmul(wp, c16), w2 = cmul(w1, w1), w3 = cmul(w2, w1);
                e[m + 4] = cmulc(e[m + 4], w1); e[m + 8] = cmulc(e[m + 8], w2); e[m + 12] = cmulc(e[m + 12], w3);
                bfly4i(e[m], e[m + 4], e[m + 8], e[m + 12]);
            }
        }
#pragma unroll
        for (int m = 0; m < 16; ++m) buf[swz(base + m * T)] = e[m];
    }
    __syncthreads();
}
template <bool INV> DI void fft_pass4_s1(LAS f32x2v* buf, int tid) {
    asm volatile("" : "+v"(tid));
#pragma unroll 2
    for (int it = 0; it < 8; ++it) {
        const int b = swz((tid + 512 * it) << 2);
        f32x2v a0 = buf[b], a1 = buf[b + 1], a2 = buf[b + 2], a3 = buf[b + 3];
        if (!INV) bfly4f(a0, a1, a2, a3); else bfly4i(a0, a1, a2, a3);
        buf[b] = a0; buf[b + 1] = a1; buf[b + 2] = a2; buf[b + 3] = a3;
    }
    __syncthreads();
}
DI void fft_fwd(LAS f32x2v* buf, int tid) { fft_pass16<1024, false>(buf, tid); fft_pass16<64, false>(buf, tid); fft_pass16<4, false>(buf, tid); fft_pass4_s1<false>(buf, tid); }
DI void fft_inv(LAS f32x2v* buf, int tid) { fft_pass4_s1<true>(buf, tid); fft_pass16<4, true>(buf, tid); fft_pass16<64, true>(buf, tid); fft_pass16<1024, true>(buf, tid); }

DI void hyena_unit(Ctx& C, int l, int c, f32x2v* park, int dry = 0) {
    LAS f32x2v* buf = (LAS f32x2v*)C.lds; LAS float* red = (LAS float*)(C.lds + 131072);
    int tid = C.tid; asm volatile("" : "+v"(tid));
    bf16* ZT = WSP(bf16, WS_ZT); const float* FT = WSP(float, WS_FT);
    bf16* u0 = ZT + (size_t)(0 * 768 + 512 + c) * SEQ; bf16* u1 = ZT + (size_t)(1 * 768 + 512 + c) * SEQ;
    f32x2v* spec = park + SEQ;
#pragma unroll 1
    for (int o = 0; o < 2; ++o) {
        const float* hf = FT + (size_t)((o * 2 + 0) * 256 + c) * SEQ; const float* hb = FT + (size_t)((o * 2 + 1) * 256 + c) * SEQ;
        const bf16* g0 = ZT + (size_t)(0 * 768 + o * 256 + c) * SEQ; const bf16* g1 = ZT + (size_t)(1 * 768 + o * 256 + c) * SEQ;
        const float skip = INP(31)[(l * 2 + o) * 256 + c];
        if (o == 0) {
#pragma unroll 32
            for (int n = tid; n < SEQ; n += NTHR) buf[swz(n)] = (f32x2v){bf2f(u0[n]), bf2f(u1[n])};
        }
        __syncthreads(); fft_fwd(buf, tid);
        float sabs = 0.f;
#pragma unroll 32
        for (int n = tid; n < SEQ; n += NTHR) spec[n] = buf[swz(n)];
#pragma unroll 32
        for (int n = tid; n < SEQ; n += NTHR) { const float a = hf[n], b = n ? hb[SEQ - n] : 0.f; sabs += fabsf(a) + fabsf(b); buf[swz(n)] = (f32x2v){a + b, 0.f}; }
        __syncthreads(); fft_fwd(buf, tid);
#pragma unroll 32
        for (int n = tid; n < SEQ; n += NTHR) { const int ns = swz(n); buf[ns] = cmul(buf[ns], spec[n]); }
        __syncthreads(); fft_inv(buf, tid);
#pragma unroll 32
        for (int n = tid; n < SEQ; n += NTHR) park[n] = buf[swz(n)];
#pragma unroll 32
        for (int n = tid; n < SEQ; n += NTHR) { const float fr = (float)n * (1.0f / 32768.0f); const f32x2v wv = (f32x2v){__builtin_amdgcn_cosf(fr), -__builtin_amdgcn_sinf(fr)};
            buf[swz(n)] = cmul((f32x2v){bf2f(u0[n]), bf2f(u1[n])}, wv); }
        __syncthreads(); fft_fwd(buf, tid);
#pragma unroll 32
        for (int n = tid; n < SEQ; n += NTHR) spec[n] = buf[swz(n)];
#pragma unroll 32
        for (int n = tid; n < SEQ; n += NTHR) { const float a = hf[n], b = n ? hb[SEQ - n] : 0.f; const float fr = (float)n * (1.0f / 32768.0f); const float d = a - b;
            buf[swz(n)] = (f32x2v){d * __builtin_amdgcn_cosf(fr), -d * __builtin_amdgcn_sinf(fr)}; }
        __syncthreads(); fft_fwd(buf, tid);
#pragma unroll 32
        for (int n = tid; n < SEQ; n += NTHR) { const int ns = swz(n); buf[ns] = cmul(buf[ns], spec[n]); }
        __syncthreads(); fft_inv(buf, tid);
        sabs = wave_sum(sabs); if (C.lane == 0) red[C.wave] = sabs;
        __syncthreads();
        float tot = 0.f;
#pragma unroll
        for (int w = 0; w < 8; ++w) tot += red[w];
        const float nrm = 1.0f / (32768.0f * tot);
#pragma unroll 1
        for (int n0 = tid; n0 < SEQ; n0 += 8 * NTHR) {
            f32x2v pk[8]; unsigned short r0[8], r1[8], q0[8], q1[8];
#pragma unroll
            for (int k = 0; k < 8; ++k) { const int n = n0 + NTHR * k; pk[k] = park[n]; r0[k] = u0[n]; r1[k] = u1[n]; q0[k] = g0[n]; q1[k] = g1[n]; }
#pragma unroll
            for (int k = 0; k < 8; ++k) { const int n = n0 + NTHR * k; const float fr = (float)n * (1.0f / 32768.0f); const f32x2v wc = (f32x2v){__builtin_amdgcn_cosf(fr), __builtin_amdgcn_sinf(fr)};
                const f32x2v cv = (pk[k] + cmul(buf[swz(n)], wc)) * nrm; const float x0 = bf2f(r0[k]), x1 = bf2f(r1[k]);
                const float y0 = bf2f(q0[k]) * (cv.x + skip * x0), y1 = bf2f(q1[k]) * (cv.y + skip * x1);
                if (dry) { if (y0 == 1.2345e30f) u0[n] = 0; }
                else if (o == 0) { const unsigned b0 = f2bf(y0), b1 = f2bf(y1); u0[n] = (bf16)b0; u1[n] = (bf16)b1; buf[swz(n)] = (f32x2v){bf2f(b0), bf2f(b1)}; }
                else { WSP(bf16, WS_YDT)[(size_t)(0 * 256 + c) * SEQ + n] = (bf16)f2bf(y0); WSP(bf16, WS_YDT)[(size_t)(1 * 256 + c) * SEQ + n] = (bf16)f2bf(y1); } }
        }
        __syncthreads();
    }
}

DI void hyena_ctx_unit(Ctx& C, int l, int c) {
    LAS float* hh = (LAS float*)C.lds; LAS float* us = hh + 512; LAS float* red = us + 512;
    int tid = C.tid; asm volatile("" : "+v"(tid)); const int b = tid >> 8, t = tid & 255; const bf16* ZTC = WSP(bf16, WS_ZTC); const float* FTC = WSP(float, WS_FTC);
    float u = bf2f(ZTC[(size_t)(b * 768 + 512 + c) * CTXL + t]);
    for (int o = 0; o < 2; ++o) {
        float av = 0.f;
        if (tid < 511) { const int i = tid - 255; const float v = (i >= 0) ? FTC[(size_t)((o * 2 + 0) * 256 + c) * CTXL + i] : FTC[(size_t)((o * 2 + 1) * 256 + c) * CTXL - i]; hh[tid] = v; av = fabsf(v); }
        us[b * 256 + t] = u;
        av = wave_sum(av); if ((tid & 63) == 0) red[tid >> 6] = av;
        __syncthreads();
        float tot = 0.f;
#pragma unroll
        for (int w = 0; w < 8; ++w) tot += red[w];
        float acc = 0.f;
#pragma unroll 16
        for (int s2 = 0; s2 < 256; ++s2) acc += hh[255 + t - s2] * us[b * 256 + s2];
        const float gate = bf2f(ZTC[(size_t)(b * 768 + o * 256 + c) * CTXL + t]); const float skip = INP(31)[(l * 2 + o) * 256 + c];
        u = gate * (acc / tot + skip * u);
        __syncthreads();
    }
    WSP(bf16, WS_YDTC)[(size_t)(b * 256 + c) * CTXL + t] = (bf16)f2bf(u);
}

DI void ydt_transpose(Ctx& C, const Tile& T) {
    LAS bf16* ts = (LAS bf16*)C.lds;
    int tid = C.tid; asm volatile("" : "+v"(tid));
#pragma unroll
    for (int i = 0; i < 4; ++i) { const int task = tid + 512 * i, ch = task >> 3, chunk = task & 7;
        const bf16* src = T.lat ? WSP(bf16, WS_YDT) + (size_t)(T.b * 256 + ch) * SEQ + T.p0 + chunk * 8 : WSP(bf16, WS_YDTC) + (size_t)(T.b * 256 + ch) * CTXL + T.p0 + chunk * 8;
        *(LAS u32x4*)(ts + ch * 72 + chunk * 8) = *(const u32x4*)src; }
    __syncthreads();
    const int tok = tid >> 3, cg8 = tid & 7;
#pragma unroll
    for (int q = 0; q < 4; ++q) { unsigned short e[8];
#pragma unroll
        for (int j = 0; j < 8; ++j) e[j] = ts[(cg8 * 32 + q * 8 + j) * 72 + tok];
        u32x4 w; w.x = e[0] | ((unsigned)e[1] << 16); w.y = e[2] | ((unsigned)e[3] << 16); w.z = e[4] | ((unsigned)e[5] << 16); w.w = e[6] | ((unsigned)e[7] << 16);
        *(u32x4*)(WSP(bf16, WS_MIX) + (size_t)(T.m0 + tok) * DM + 768 + cg8 * 32 + q * 8) = w; }
    __syncthreads();
}
#define XB_TMO      128
#define XB_XCNT(j)  (256  + 64 * (j))
#define XB_XSUB(j)  (1280 + 64 * (j))
#define XB_XGEN(j)  (2304 + 64 * (j))
#define XB_TOP      3328
#define XB_TOPGEN   3392
#define XCD_BAR_WORDS 3456
#define XB_SPIN_CAP (1u << 18)

__device__ __forceinline__ unsigned xb_ld(unsigned* p)              { return __hip_atomic_load(p, __ATOMIC_RELAXED, __HIP_MEMORY_SCOPE_AGENT); }
__device__ __forceinline__ unsigned xb_add(unsigned* p, unsigned v) { return __hip_atomic_fetch_add(p, v, __ATOMIC_RELAXED, __HIP_MEMORY_SCOPE_AGENT); }
__device__ __forceinline__ unsigned xb_xcc_id() { return (unsigned)__builtin_amdgcn_s_getreg((3 << 11) | 20) & 0xFu; }
#define XB_SPIN(cond, bar) do { unsigned _sp = 0; while (cond) { __builtin_amdgcn_s_sleep(1); \
    if ((++_sp & 255u) == 0u) { if (xb_ld(&(bar)[XB_TMO])) break; if (_sp > XB_SPIN_CAP) { atomicAdd(&(bar)[XB_TMO], 1u); break; } } } } while (0)

struct XcdBarrier {
    unsigned* bar; unsigned x;
    volatile LAS unsigned* st;
};

__device__ __forceinline__ XcdBarrier xcd_barrier_post(unsigned* bar, volatile LAS unsigned* st) {
    XcdBarrier b; b.bar = bar; b.x = xb_xcc_id(); b.st = st;
    if (threadIdx.x == 0) (void)xb_add(&bar[XB_XCNT(b.x)], 1u);
    return b;
}
__device__ __forceinline__ void xcd_barrier_complete(unsigned* bar, unsigned x, unsigned& nloc, unsigned& nx) {
    const unsigned G = gridDim.x * gridDim.y * gridDim.z;
    unsigned sum, cnt, mine, sp = 0u;
    for (;;) {
        sum = 0u; cnt = 0u; mine = 0u;
#pragma unroll
        for (unsigned j = 0; j < 16; ++j) { const unsigned c = xb_ld(&bar[XB_XCNT(j)]); sum += c; cnt += (c > 0u) ? 1u : 0u; mine = (j == x) ? c : mine; }
        if (sum == G) break;
        __builtin_amdgcn_s_sleep(1);
        if ((++sp & 255u) == 0u) { if (xb_ld(&bar[XB_TMO])) break; if (sp > XB_SPIN_CAP) { atomicAdd(&bar[XB_TMO], 1u); break; } }
    }
    nloc = mine > 0u ? mine : 1u; nx = cnt > 0u ? cnt : 1u;
}

__device__ __forceinline__ void xcd_barrier(const XcdBarrier& b) {
    asm volatile("s_waitcnt vmcnt(0)" ::: "memory");
    __syncthreads();
    if (threadIdx.x == 0) {
        unsigned* bar = b.bar;
        __builtin_amdgcn_s_waitcnt(0);
        unsigned nloc = b.st[0], nx = b.st[1];
        if (nloc == 0u) { xcd_barrier_complete(bar, b.x, nloc, nx); b.st[0] = nloc; b.st[1] = nx; }
        const unsigned old = xb_add(&bar[XB_XSUB(b.x)], 1u);
        const unsigned gen = old / nloc;
        if (old + 1u == (gen + 1u) * nloc) {
            __builtin_amdgcn_fence(__ATOMIC_RELEASE, "agent");
            asm volatile("s_waitcnt vmcnt(0)" ::: "memory");
            const unsigned og = xb_add(&bar[XB_TOP], 1u);
            const unsigned tg = og / nx;
            if (og + 1u == (tg + 1u) * nx) xb_add(&bar[XB_TOPGEN], 1u);
            else XB_SPIN(xb_ld(&bar[XB_TOPGEN]) == tg, bar);
            __builtin_amdgcn_fence(__ATOMIC_ACQUIRE, "agent");
            xb_add(&bar[XB_XGEN(b.x)], 1u);
            asm volatile("s_waitcnt vmcnt(0)" ::: "memory");
        } else {
            XB_SPIN(xb_ld(&bar[XB_XGEN(b.x)]) == gen, bar);
            __builtin_amdgcn_fence(__ATOMIC_ACQUIRE, "agent");
            asm volatile("s_waitcnt vmcnt(0)" ::: "memory");
        }
    }
    __syncthreads();
}
DI void rows_phase(Ctx& C, int l, int which) {
    const int gw = C.bid * NWV + C.wave, NGW = C.G * NWV; const float* MOD = WSP(float, WS_MOD);
#ifndef NO_ROWS
    if (which == 1) {
        for (int m = gw; m < MTOT; m += NGW) { const int cond = row_cond(m); const bool lat = m < MLAT; const float* modl = MOD + (size_t)cond * 6144;
            row_norm_mod(lat ? INP(0) + (size_t)m * DM : INP(2) + (size_t)(m - MLAT) * DM, INP(6), modl, modl + 1024, WSP(bf16, WS_XN) + (size_t)m * DM, C.lane); }
        return;
    }
    constexpr int NR = 4;
    LAS float* PV = (LAS float*)C.lds;
    {
        const bool nxt = (l + 1 < DEPTH); const int ln = (which == 2) ? l : (nxt ? l + 1 : l);
        f32x4 pvr[8];
#pragma unroll
        for (int i = 0; i < 8; ++i) { const int e0 = C.tid + NTHR * i, e = e0 < 3 * 5 * 256 ? e0 : 3 * 5 * 256 - 1; const int cond = e / 1280, v = (e / 256) % 5, c4 = (e & 255) * 4;
            const float* modl = MOD + (size_t)(l * 3 + cond) * 6144; const float* modn = MOD + (size_t)(ln * 3 + cond) * 6144; const float* src;
            if (which == 2) src = (v == 0) ? INP(7) + l * DM : (v == 1) ? modl + 2048 : (v == 2) ? INP(8) + l * DM : (v == 3) ? modl + 3072 : modl + 4096;
            else src = (v == 0) ? INP(9) + l * DM : (v == 1) ? modl + 5120 : (v == 2) ? INP(6) + ln * DM : (v == 3) ? modn : modn + 1024;
            pvr[i] = *(const f32x4*)(src + c4); }
#pragma unroll
        for (int i = 0; i < 8; ++i) { const int e = C.tid + NTHR * i; if (e < 3 * 5 * 256) *(LAS f32x4*)(PV + (e / 256) * 1024 + (e & 255) * 4) = pvr[i]; }
        __syncthreads();
    }
    const int Mr = (l == DEPTH - 1) ? MLAT : MTOT;
    for (int m0 = gw * NR; m0 < Mr; m0 += NGW * NR) {
        const int cond = row_cond(m0); const bool lat = m0 < MLAT; const LAS float* pv = PV + cond * 5 * 1024;
        const float* xi[NR]; const bf16* y[NR]; float* xo[NR]; bf16* xn[NR];
#pragma unroll
        for (int q = 0; q < NR; ++q) { const int m = m0 + q;
            float* xcur = lat ? C.out + (size_t)m * DM : WSP(float, WS_CX) + (size_t)(m - MLAT) * DM;
            const float* xorig = lat ? INP(0) + (size_t)m * DM : INP(2) + (size_t)(m - MLAT) * DM;
            xi[q] = (which == 2 && l == 0) ? xorig : xcur; xo[q] = xcur; xn[q] = WSP(bf16, WS_XN) + (size_t)m * DM;
            y[q] = (which == 2 ? WSP(bf16, WS_PX) : WSP(bf16, WS_MIX)) + (size_t)m * DM; }
        row_update<NR>(xi, y, pv, pv + 1024, xo, pv + 2048, pv + 3072, pv + 4096, xn, which == 2 || (l + 1 < DEPTH), C.lane);
    }
    __syncthreads();
#endif
}
DI void ft_phase(Ctx& C, int l) {
    for (int rep_ = 0; rep_ < (PROBE_FT ? 2 : 1); ++rep_)
    for (int it = C.bid; it < 256 + (l == 0 ? 4 : 0); it += C.G) {
        if (it < 256) ft_item(C, WSP(float, WS_H2) + (size_t)l * SEQ * 64, WSP(float, WS_W3T) + (size_t)l * 65536, WSP(float, WS_FT), SEQ, it * 64);
        else ft_item(C, WSP(float, WS_H2C), WSP(float, WS_W3T), WSP(float, WS_FTC), CTXL, (it - 256) * 64);
    }
}
template <int ACT> DI void gemm_run(Ctx& C, const bf16* A, const bf16* Bt, int M, int N, int K, bf16* O) {
    pg8::Gemm g{A, Bt, M, N, K}; pg8::StaticOrder S; S.init(M, N, C.G, C.bid);
    pg8::EpiBf16<ACT> E{O, N};
#ifndef NO_GEMM
    for (int rep_ = 0; rep_ < (PROBE_GEMM ? 2 : 1); ++rep_)
    pg8::gemm_phase<pg8::EpiBf16<ACT>, pg8::StaticOrder, true, true>((PG8_LAS unsigned char*)C.lds, g, S, E);
#endif
    __syncthreads();
}

#define GSYNC() do { xcd_barrier(bar); if (PROBE_SYNC) xcd_barrier(bar); } while (0)
#define RELAUNDER() do { int t_ = threadIdx.x; asm volatile("" : "+v"(t_)); C.tid = t_; C.lane = t_ & 63; } while (0)
__global__ void __launch_bounds__(NTHR, 2) fwd_megakernel(Args args) {
    extern __shared__ __attribute__((aligned(16))) unsigned char lds_raw[];
    cg::grid_group grid = cg::this_grid();
    Ctx C; C.in = args.in; C.out = args.out; C.ws = args.ws; C.lds = (LAS unsigned char*)lds_raw;
    C.tid = threadIdx.x; C.lane = C.tid & 63; C.wave = __builtin_amdgcn_readfirstlane(C.tid >> 6); C.G = gridDim.x; C.bid = blockIdx.x;
    volatile LAS unsigned* bst = (volatile LAS unsigned*)(C.lds + 131072 + 256);
    if (threadIdx.x < 2) bst[threadIdx.x] = 0u;
    __syncthreads();
    XcdBarrier bar = xcd_barrier_post((unsigned*)args.ws, bst);

#ifndef NO_P0
    phase0(C);
    if (PROBE_P0) { __syncthreads(); RELAUNDER(); phase0(C); }
#endif
    grid.sync(); RELAUNDER();
    rows_phase(C, 0, 1); RELAUNDER();
#ifndef NO_FT
    ft_phase(C, 0);
#endif
    GSYNC(); RELAUNDER();
    for (int l = 0; l < DEPTH; ++l) {
        gemm_run<0>(C, WSP(bf16, WS_XN), WSP(bf16, WS_WIN) + (size_t)l * INC * DM, MTOT, INC, DM, WSP(bf16, WS_PX));
        GSYNC(); RELAUNDER();
#ifndef NO_PREP
        for (int rep_ = 0; rep_ < (PROBE_PREP ? 2 : 1); ++rep_)
        for (int it = C.bid; it < NTILE64 * 9; it += C.G) {
            const int tt = it / 9, sub = it % 9; const Tile T = tile_of(tt);
            if (sub == 0) prep_qkv(C, l, T);
            else if (sub <= 3) prep_hyena(C, l, T, sub - 1);
            else if (sub == 4) prep_pool(C, l, T);
#ifndef NO_LRU
            else lru_item<1>(C, l, T, sub - 5);
#endif
        }
#endif
        GSYNC(); RELAUNDER();
        {
            lru_carry(C);
            const int nat = 256 + (l == 0 ? 8 : 0);
#ifndef NO_ATT
            for (int rep_ = 0; rep_ < (PROBE_ATT ? 2 : 1); ++rep_)
            for (int u = C.bid; u < nat; u += C.G) {
                if (u < 256) { const int b = u >> 7, h = (u >> 5) & 3, qt = u & 31, kvh = h >> 1;
                    attn_unit(C, WSP(bf16, WS_Q) + (size_t)(b * 4 + h) * SEQ * 64, WSP(bf16, WS_K) + (size_t)(b * 2 + kvh) * SKV * 64, WSP(bf16, WS_VT) + (size_t)(b * 2 + kvh) * 64 * SKV, SKV / 64,
                              WSP(bf16, WS_MIX) + (size_t)(b * SEQ) * DM + 256 + h * 64, qt * 512, 512); }
                else { const int uc = u - 256, b = uc >> 2, h = uc & 3, kvh = h >> 1;
                    attn_unit(C, WSP(bf16, WS_QC) + (size_t)(b * 4 + h) * CTXL * 64, WSP(bf16, WS_K) + (size_t)(b * 2 + kvh) * SKV * 64, WSP(bf16, WS_VT) + (size_t)(b * 2 + kvh) * 64 * SKV, CTXL / 64,
                              WSP(bf16, WS_MIX) + (size_t)(MLAT + b * CTXL) * DM + 256 + h * 64, 0, 256); }
            }
#endif
            RELAUNDER();
#ifndef NO_HY
#if PROBE_HY
            for (int c = C.bid; c < 256; c += C.G) hyena_unit(C, l, c, (f32x2v*)(C.ws + WS_XN) + (size_t)C.bid * 2 * SEQ, 1);
            RELAUNDER();
#endif
            for (int c = C.bid; c < 256; c += C.G) hyena_unit(C, l, c, (f32x2v*)(C.ws + WS_XN) + (size_t)C.bid * 2 * SEQ);
#endif
            RELAUNDER();
#ifndef NO_HYC
            if (l == 0) for (int c = C.bid; c < 256; c += C.G) hyena_ctx_unit(C, l, c);
#endif
        }
        GSYNC(); RELAUNDER();
#ifndef NO_TR
        for (int rep_ = 0; rep_ < (PROBE_TR ? 2 : 1); ++rep_)
        for (int tt = C.bid; tt < NTILE64; tt += C.G) ydt_transpose(C, tile_of(tt));
#endif
        RELAUNDER();
#ifndef NO_LRU
        for (int rep_ = 0; rep_ < (PROBE_TR ? 2 : 1); ++rep_)
        for (int it = C.bid; it < NTILE64 * 4; it += C.G) lru_item<2>(C, l, tile_of(it >> 2), it & 3);
#endif
        GSYNC(); RELAUNDER();
        const int Mg = (l == DEPTH - 1) ? MLAT : MTOT;
        gemm_run<0>(C, WSP(bf16, WS_MIX), WSP(bf16, WS_WOUT) + (size_t)l * DM * DM, Mg, DM, DM, WSP(bf16, WS_PX));
        GSYNC(); RELAUNDER();
        rows_phase(C, l, 2);
        if (PROBE_ROWS && l == 0) { RELAUNDER(); rows_phase(C, l, 2); }
        GSYNC(); RELAUNDER();
        gemm_run<2>(C, WSP(bf16, WS_XN), WSP(bf16, WS_W1) + (size_t)l * DFF * DM, Mg, DFF, DM, WSP(bf16, WS_PX));
        GSYNC(); RELAUNDER();
        gemm_run<0>(C, WSP(bf16, WS_PX), WSP(bf16, WS_W2) + (size_t)l * DM * DFF, Mg, DM, DFF, WSP(bf16, WS_MIX));
        GSYNC(); RELAUNDER();
        rows_phase(C, l, 3); RELAUNDER();
        if (l + 1 < DEPTH) {
#ifndef NO_FT
            ft_phase(C, l + 1);
#endif
            GSYNC(); RELAUNDER(); }
    }
}

extern "C" void kernel_launch(void* const* d_in, const int* in_sizes, int n_in, void* d_out, int out_size, void* d_ws, size_t ws_size, hipStream_t stream) {
    static int grid_blocks = 0;
    if (grid_blocks == 0) {
        if (n_in != 34 || ws_size < WS_END) { fprintf(stderr, "kernel_launch: unexpected n_in %d / ws %zu\n", n_in, ws_size); grid_blocks = -1; return; }
        int dev = 0, cus = 0, per_cu = 0;
        hipGetDevice(&dev); hipDeviceGetAttribute(&cus, hipDeviceAttributeMultiprocessorCount, dev);
        if (hipFuncSetAttribute((const void*)fwd_megakernel, hipFuncAttributeMaxDynamicSharedMemorySize, LDS_BYTES) != hipSuccess) { fprintf(stderr, "kernel_launch: hipFuncSetAttribute failed\n"); }
        if (hipOccupancyMaxActiveBlocksPerMultiprocessor(&per_cu, (const void*)fwd_megakernel, NTHR, LDS_BYTES) != hipSuccess || per_cu < 1) per_cu = 1;
        (void)hipGetLastError();
        grid_blocks = cus * per_cu; if (grid_blocks > 256) grid_blocks = 256;
    }
    if (grid_blocks < 0) return;
    Args a{};
    for (int i = 0; i < 34; ++i) a.in[i] = (const float*)d_in[i];
    a.out = (float*)d_out; a.ws = (unsigned char*)d_ws;
    void* kargs[] = {&a};
    if (hipMemsetAsync(d_ws, 0, 65536, stream) != hipSuccess) { fprintf(stderr, "kernel_launch: memset failed\n"); return; }
    hipError_t e = hipLaunchCooperativeKernel((const void*)fwd_megakernel, dim3(grid_blocks), dim3(NTHR), kargs, LDS_BYTES, stream);
    if (e != hipSuccess) fprintf(stderr, "cooperative launch failed: %s (grid %d)\n", hipGetErrorString(e), grid_blocks);
}
```

```cpp
#include <hip/hip_runtime.h>
#include <hip/hip_cooperative_groups.h>
#include <cstdio>
#include <cstdint>
namespace cg = cooperative_groups;
#ifndef PROBE_ATT
#define PROBE_ATT 0
#endif
#ifndef PROBE_GEMM
#define PROBE_GEMM 0
#endif
#ifndef PROBE_PREP
#define PROBE_PREP 0
#endif
#ifndef PROBE_HY
#define PROBE_HY 0
#endif
#ifndef PROBE_SYNC
#define PROBE_SYNC 0
#endif
#ifndef PROBE_P0
#define PROBE_P0 0
#endif
#ifndef PROBE_FT
#define PROBE_FT 0
#endif
#ifndef PROBE_TR
#define PROBE_TR 0
#endif
#ifndef PROBE_ROWS
#define PROBE_ROWS 0
#endif
namespace pg8 {
#define PG8_LAS __attribute__((address_space(3)))
typedef unsigned short bf16_t;
typedef short bf16x8 __attribute__((ext_vector_type(8)));
typedef float f32x4 __attribute__((ext_vector_type(4)));
typedef unsigned u32x4 __attribute__((ext_vector_type(4)));
constexpr int BM = 256, BK = 64, HALF = 128, HTB = HALF * BK * 2  , STAGE_BYTES = 8 * HTB, NXCD = 8, WGM = 8;

__host__ __device__ __forceinline__ int lds_byte(int r, int c) { const int st = (r >> 4) * 2 + (c >> 5), rr = r & 15, cc = c & 31, ob = rr * 64 + cc * 2; return st * 1024 + (ob ^ (((ob >> 9) & 1) << 5)); }
__host__ __device__ __forceinline__ void stage_rc(int b, int& R, int& C) { const int st = b / 1024, sb = b % 1024, swz = sb ^ (((sb >> 9) & 1) << 5); R = (st >> 1) * 16 + swz / 64; C = (st & 1) * 32 + (swz % 64) / 2; }
__host__ __device__ __forceinline__ int perm32(int rho) { const int n = rho >> 4, i = rho & 15; return 8 * (i >> 2) + 4 * n + (i & 3); }

struct Unit { int pm, pn; };
struct Gemm { const bf16_t* A; const bf16_t* Bt; int M, N, K; };

struct StaticOrder {
    int nM, nN, nwg, G, c;
    __host__ __device__ void init(int M, int N, int G_, int c_) { nM = M / BM; nN = N / BM; nwg = nM * nN; G = G_; c = c_; }
    __host__ __device__ bool next(int i, Unit& u) const {
        const long L = (long)i * G + c; if (L >= nwg) return false;
        int wgid = (int)L; { const int q = nwg / NXCD, r = nwg % NXCD, xcd = wgid % NXCD, off = wgid / NXCD; wgid = (xcd < r ? xcd * (q + 1) : r * (q + 1) + (xcd - r) * q) + off; }
        const int nig = WGM * nN, gid = wgid / nig, fm = gid * WGM, gsz = (nM - fm) < WGM ? (nM - fm) : WGM;
        u.pm = fm + ((wgid % nig) % gsz); u.pn = (wgid % nig) / gsz; return true;
    }
    __device__ __forceinline__ void a_ready(const Unit&) const {}
    __device__ __forceinline__ void done(const Unit&) const {}
};
__device__ __forceinline__ unsigned cvt_pk_bf16(float lo, float hi) { unsigned r; asm volatile("v_cvt_pk_bf16_f32 %0, %1, %2" : "=v"(r) : "v"(lo), "v"(hi)); return r; }
typedef float f32x2 __attribute__((ext_vector_type(2)));template <int ACT  > struct EpiBf16 {
    static constexpr bool PERM = true, AFTER_DRAIN = false;
    bf16_t* O; int ldc;
    __device__ __forceinline__ void operator()(const f32x4 (&acc)[2][2][4][2], const Unit& u, int wr, int wc, int fr, int fq) const {
        const int row0 = u.pm * BM + wr * 64 + fr; const int col0 = u.pn * BM + wc * 32 + 8 * fq;
#pragma unroll
        for (int ai = 0; ai < 2; ++ai)
#pragma unroll
            for (int m = 0; m < 4; ++m) { bf16_t* rowp = O + (size_t)(row0 + ai * HALF + m * 16) * ldc + col0;
#pragma unroll
                for (int bj = 0; bj < 2; ++bj) { f32x4 v0 = acc[ai][bj][m][0], v1 = acc[ai][bj][m][1];
                    if (ACT == 2) {
#pragma unroll
                        for (int e = 0; e < 4; ++e) { float a = v0[e] > 0.f ? v0[e] : 0.f; v0[e] = a * a; float b = v1[e] > 0.f ? v1[e] : 0.f; v1[e] = b * b; } }
                    u32x4 w; w.x = cvt_pk_bf16(v0[0], v0[1]); w.y = cvt_pk_bf16(v0[2], v0[3]); w.z = cvt_pk_bf16(v1[0], v1[1]); w.w = cvt_pk_bf16(v1[2], v1[3]);
                    *(u32x4*)(rowp + bj * HALF) = w; } }
    }
};
template <class Epi, class Sched, bool ALIGN_EPI = false, bool SP2 = false>
__device__ __forceinline__ void gemm_phase(PG8_LAS unsigned char* lds, const Gemm g, const Sched& S, const Epi& E) {
    int tid_ = threadIdx.x; asm volatile("" : "+v"(tid_)); const int tid = tid_, wid = __builtin_amdgcn_readfirstlane(tid >> 6), lane = tid & 63, wr = wid >> 2, wc = wid & 3, fr = lane & 15, fq = lane >> 4;
    const int K = g.K, nt = K / BK;
    unsigned voffA[2], voffB[2];
#pragma unroll
    for (int i = 0; i < 2; ++i) { int R, C; stage_rc(tid * 16 + i * 8192, R, C); const int Rb = Epi::PERM ? ((R & ~31) + perm32(R & 31)) : R;
        voffA[i] = (unsigned)(R * K + C) * 2u; voffB[i] = (unsigned)(Rb * K + C) * 2u; }
    const size_t kstep = (size_t)(BK * 2);
    const size_t hstep = (size_t)HALF * K * 2;
    const size_t tstep = 2 * hstep;
    const unsigned ldsw = (unsigned)wid * 1024u;
    const int aoff = lds_byte(wr * 64 + fr, fq * 8), boff = lds_byte(wc * 32 + fr, fq * 8);
#define PG8_SA(b, h) (((b) * 2 + (h)) * HTB)
#define PG8_SB(b, h) ((4 + (b) * 2 + (h)) * HTB)
#define PG8_STAGE(bufoff, gbase, voff) do { _Pragma("unroll") for (int _i = 0; _i < 2; ++_i) \
        __builtin_amdgcn_global_load_lds((const unsigned*)((const char*)(gbase) + (voff)[_i]), (PG8_LAS unsigned*)(lds + (bufoff) + ldsw + _i * 8192), 16, 0, 0); } while (0)
#define PG8_LDA(dst, b, h) do { _Pragma("unroll") for (int m = 0; m < 4; ++m) _Pragma("unroll") for (int k = 0; k < 2; ++k) dst[m][k] = *(const PG8_LAS bf16x8*)(lds + PG8_SA(b, h) + aoff + m * 2048 + k * 1024); } while (0)
#define PG8_LDB(dst, b, h) do { _Pragma("unroll") for (int n = 0; n < 2; ++n) _Pragma("unroll") for (int k = 0; k < 2; ++k) dst[n][k] = *(const PG8_LAS bf16x8*)(lds + PG8_SB(b, h) + boff + n * 2048 + k * 1024); } while (0)
#define PG8_MMA(ai, bj, At, Bt) do { __builtin_amdgcn_s_setprio(1); _Pragma("unroll") for (int m = 0; m < 4; ++m) _Pragma("unroll") for (int n = 0; n < 2; ++n) _Pragma("unroll") for (int k = 0; k < 2; ++k) \
        acc[ai][bj][m][n] = __builtin_amdgcn_mfma_f32_16x16x32_bf16(Bt[n][k], At[m][k], acc[ai][bj][m][n], 0, 0, 0); __builtin_amdgcn_s_setprio(0); } while (0)
#define PG8_WAIT_V(n) asm volatile("s_waitcnt vmcnt(" #n ")" ::: "memory")
#define PG8_WAIT_L(n) asm volatile("s_waitcnt lgkmcnt(" #n ")" ::: "memory")
#define PG8_BAR __builtin_amdgcn_s_barrier()
#define PG8_SCHED __builtin_amdgcn_sched_barrier(0)
    Unit cur, nxt; int ui = 0;
    if (!S.next(0, cur)) return;
    f32x4 acc[2][2][4][2];
#pragma unroll
    for (int a = 0; a < 2; ++a)
#pragma unroll
        for (int b = 0; b < 2; ++b)
#pragma unroll
            for (int m = 0; m < 4; ++m)
#pragma unroll
                for (int n = 0; n < 2; ++n) acc[a][b][m][n] = (f32x4){0.f, 0.f, 0.f, 0.f};
    bf16x8 At[4][2], B0[2][2], B1[2][2];
    const char* cA = (const char*)g.A + (size_t)cur.pm * tstep; const char* cB = (const char*)g.Bt + (size_t)cur.pn * tstep;
    S.a_ready(cur);
    if constexpr (SP2) {
        PG8_STAGE(PG8_SB(0, 0), cB, voffB); PG8_STAGE(PG8_SB(0, 1), cB + hstep, voffB); PG8_STAGE(PG8_SA(0, 0), cA, voffA); PG8_STAGE(PG8_SA(0, 1), cA + hstep, voffA);
        if (wr == 1) PG8_BAR;
        PG8_WAIT_V(2); PG8_BAR;
        PG8_STAGE(PG8_SB(1, 0), cB + kstep, voffB); PG8_STAGE(PG8_SA(1, 0), cA + kstep, voffA); PG8_STAGE(PG8_SB(1, 1), cB + hstep + kstep, voffB);
        PG8_WAIT_V(6); PG8_BAR;
    } else {
        PG8_STAGE(PG8_SB(0, 0), cB, voffB); PG8_STAGE(PG8_SA(0, 0), cA, voffA); PG8_STAGE(PG8_SB(0, 1), cB + hstep, voffB); PG8_STAGE(PG8_SA(0, 1), cA + hstep, voffA);
        if (wr == 1) PG8_BAR;
        PG8_WAIT_V(4); PG8_BAR;
        PG8_STAGE(PG8_SB(1, 0), cB + kstep, voffB); PG8_STAGE(PG8_SA(1, 0), cA + kstep, voffA); PG8_STAGE(PG8_SB(1, 1), cB + hstep + kstep, voffB);
        PG8_WAIT_V(6); PG8_BAR;
    }
    for (;;) {
        const bool has_next = S.next(ui + 1, nxt);
        const char* nA = has_next ? (const char*)g.A + (size_t)nxt.pm * tstep : cA; const char* nB = has_next ? (const char*)g.Bt + (size_t)nxt.pn * tstep : cB;
        for (int t = 0; t < nt; t += 2) {
            const bool last = (t == nt - 2);
            const char* a1 = cA + (size_t)(t + 1) * kstep;
            const char* a2 = last ? nA : cA + (size_t)(t + 2) * kstep; const char* b2 = last ? nB : cB + (size_t)(t + 2) * kstep;
            const char* a3 = a2 + kstep; const char* b3 = b2 + kstep;
            if (last && has_next) S.a_ready(nxt);
            if constexpr (SP2) {
            PG8_LDB(B0, 0, 0); PG8_LDB(B1, 0, 1); PG8_SCHED; PG8_LDA(At, 0, 0); PG8_STAGE(PG8_SA(1, 1), a1 + hstep, voffA);
            PG8_WAIT_V(8); PG8_WAIT_L(0); PG8_BAR; PG8_MMA(0, 0, At, B0); PG8_MMA(0, 1, At, B1); PG8_BAR; PG8_SCHED;
            PG8_LDA(At, 0, 1); PG8_STAGE(PG8_SB(0, 0), b2, voffB); PG8_STAGE(PG8_SB(0, 1), b2 + hstep, voffB); PG8_STAGE(PG8_SA(0, 0), a2, voffA);
            PG8_WAIT_V(8); PG8_WAIT_L(0); PG8_BAR; PG8_MMA(1, 0, At, B0); PG8_MMA(1, 1, At, B1); PG8_BAR; PG8_SCHED;
            PG8_LDB(B0, 1, 0); PG8_LDB(B1, 1, 1); PG8_SCHED; PG8_LDA(At, 1, 0); PG8_STAGE(PG8_SA(0, 1), a2 + hstep, voffA);
            PG8_WAIT_V(8); PG8_WAIT_L(0); PG8_BAR; PG8_MMA(0, 0, At, B0); PG8_MMA(0, 1, At, B1); PG8_BAR; PG8_SCHED;
            PG8_LDA(At, 1, 1); PG8_STAGE(PG8_SB(1, 0), b3, voffB); PG8_STAGE(PG8_SB(1, 1), b3 + hstep, voffB); PG8_STAGE(PG8_SA(1, 0), a3, voffA);
            PG8_WAIT_V(8); PG8_WAIT_L(0); PG8_BAR; PG8_MMA(1, 0, At, B0); PG8_MMA(1, 1, At, B1); PG8_BAR; PG8_SCHED;
            } else {
            PG8_LDB(B0, 0, 0); PG8_SCHED; PG8_LDA(At, 0, 0); PG8_STAGE(PG8_SA(1, 1), a1 + hstep, voffA);
            PG8_WAIT_L(8); PG8_BAR; PG8_WAIT_L(0); PG8_MMA(0, 0, At, B0); PG8_BAR; PG8_SCHED;
            PG8_LDB(B1, 0, 1); PG8_STAGE(PG8_SB(0, 0), b2, voffB);
            PG8_BAR; PG8_WAIT_L(0); PG8_MMA(0, 1, At, B1); PG8_BAR;
            PG8_LDA(At, 0, 1); PG8_STAGE(PG8_SA(0, 0), a2, voffA);
            PG8_BAR; PG8_WAIT_L(0); PG8_MMA(1, 0, At, B0); PG8_BAR; PG8_SCHED;
            PG8_STAGE(PG8_SB(0, 1), b2 + hstep, voffB);
            PG8_WAIT_V(6); PG8_BAR; PG8_MMA(1, 1, At, B1); PG8_BAR;
            PG8_LDB(B0, 1, 0); PG8_SCHED; PG8_LDA(At, 1, 0); PG8_STAGE(PG8_SA(0, 1), a2 + hstep, voffA);
            PG8_WAIT_L(8); PG8_BAR; PG8_WAIT_L(0); PG8_MMA(0, 0, At, B0); PG8_BAR; PG8_SCHED;
            PG8_LDB(B1, 1, 1); PG8_STAGE(PG8_SB(1, 0), b3, voffB);
            PG8_BAR; PG8_WAIT_L(0); PG8_MMA(0, 1, At, B1); PG8_BAR;
            PG8_LDA(At, 1, 1); PG8_STAGE(PG8_SA(1, 0), a3, voffA);
            PG8_BAR; PG8_WAIT_L(0); PG8_MMA(1, 0, At, B0); PG8_BAR; PG8_SCHED;
            PG8_STAGE(PG8_SB(1, 1), b3 + hstep, voffB);
            PG8_WAIT_V(6); PG8_BAR; PG8_MMA(1, 1, At, B1); PG8_BAR;
            }
        }
        if constexpr (ALIGN_EPI) { if (wr == 0) PG8_BAR; }
        if constexpr (!Epi::AFTER_DRAIN) { E(acc, cur, wr, wc, fr, fq); S.done(cur); }
        if (!has_next) break;
#pragma unroll
        for (int a = 0; a < 2; ++a)
#pragma unroll
            for (int b = 0; b < 2; ++b)
#pragma unroll
                for (int m = 0; m < 4; ++m)
#pragma unroll
                    for (int n = 0; n < 2; ++n) acc[a][b][m][n] = (f32x4){0.f, 0.f, 0.f, 0.f};
        cur = nxt; cA = nA; cB = nB; ++ui;
        if constexpr (ALIGN_EPI) { if (wr == 1) PG8_BAR; }
    }
    PG8_WAIT_V(0);
    if constexpr (!ALIGN_EPI) { if (wr == 0) PG8_BAR; }
    PG8_BAR;
    if constexpr (Epi::AFTER_DRAIN) { E.fused(acc, cur, wr, wc, fr, fq, lds, wid, lane); S.done(cur); }
#undef PG8_SA
#undef PG8_SB
#undef PG8_STAGE
#undef PG8_LDA
#undef PG8_LDB
#undef PG8_MMA
#undef PG8_WAIT_V
#undef PG8_WAIT_L
#undef PG8_BAR
#undef PG8_SCHED
}
}
#define DI __device__ __forceinline__
#define LAS __attribute__((address_space(3)))
typedef unsigned short bf16;
typedef float f32x2v __attribute__((ext_vector_type(2)));
typedef float f32x4 __attribute__((ext_vector_type(4)));
typedef float f32x16 __attribute__((ext_vector_type(16)));
typedef short bf16x8 __attribute__((ext_vector_type(8)));
typedef short s16x4 __attribute__((ext_vector_type(4)));
typedef unsigned u32x4 __attribute__((ext_vector_type(4)));
typedef unsigned u32x2 __attribute__((ext_vector_type(2)));

constexpr int NB = 2, SEQ = 16384, CTXL = 256, DM = 1024, DEPTH = 2, INC = 2048, DFF = 4096;
constexpr int MLAT = NB * SEQ, MCTX = NB * CTXL, MTOT = MLAT + MCTX;
constexpr int SKV = CTXL + SEQ;
constexpr int NTILE64 = MTOT / 64;
constexpr int NCHUNK = SKV / 64;
constexpr float EPSN = 1e-6f;
constexpr int NTHR = 512, NWV = 8;
constexpr int LDS_BYTES = 147456;

constexpr size_t MiB = 1u << 20;
constexpr size_t WS_MOD = 1 * MiB;
constexpr size_t WS_POOLWT = 1 * MiB + 256 * 1024;
constexpr size_t WS_LRUWT = 1 * MiB + 384 * 1024;
constexpr size_t WS_WIN = 2 * MiB, WS_WOUT = 10 * MiB, WS_W1 = 14 * MiB, WS_W2 = 30 * MiB;
constexpr size_t WS_AGG = 46 * MiB;
constexpr size_t WS_CX = 49 * MiB;
constexpr size_t WS_H2 = 51 * MiB;
constexpr size_t WS_H2C = 59 * MiB;
constexpr size_t WS_W3T = 59 * MiB + 256 * 1024;
constexpr size_t WS_FTC = 60 * MiB;
constexpr size_t WS_QC = 61 * MiB;
constexpr size_t WS_XN = 62 * MiB;
constexpr size_t WS_MIX = 127 * MiB;
constexpr size_t WS_PX = 192 * MiB;
constexpr size_t WS_ZT = 322 * MiB;
constexpr size_t WS_ZTC = 370 * MiB;
constexpr size_t WS_Q = 371 * MiB;
constexpr size_t WS_K = 387 * MiB;
constexpr size_t WS_VT = 396 * MiB;
constexpr size_t WS_YDT = 405 * MiB;
constexpr size_t WS_YDTC = 421 * MiB;
constexpr size_t WS_FT = 422 * MiB;
constexpr size_t WS_CARRY = 486 * MiB;
constexpr size_t WS_END = 488 * MiB;

struct Args { const float* in[34]; float* out; unsigned char* ws; };

DI unsigned f2bf(float f) { unsigned u = __builtin_bit_cast(unsigned, f); return (u + 0x7fffu + ((u >> 16) & 1u)) >> 16; }
DI unsigned pk2(float lo, float hi) { return f2bf(lo) | (f2bf(hi) << 16); }
DI float bf2f(unsigned h) { return __builtin_bit_cast(float, h << 16); }
DI float bflo(unsigned w) { return __builtin_bit_cast(float, w << 16); }
DI float bfhi(unsigned w) { return __builtin_bit_cast(float, w & 0xffff0000u); }
DI float wave_sum(float v) {
#pragma unroll
    for (int o = 1; o < 64; o <<= 1) v += __shfl_xor(v, o);
    return v;
}
DI float sigmoidf_(float x) { return __builtin_amdgcn_rcpf(1.f + __expf(-x)); }
DI float gelu_tanh(float x) { const float u = 0.7978845608028654f * (x + 0.044715f * x * x * x); return x * __builtin_amdgcn_rcpf(1.f + __expf(-2.0f * u)); }
DI void unpack8(const u32x4 w, float* f) { f[0] = bflo(w.x); f[1] = bfhi(w.x); f[2] = bflo(w.y); f[3] = bfhi(w.y); f[4] = bflo(w.z); f[5] = bfhi(w.z); f[6] = bflo(w.w); f[7] = bfhi(w.w); }

struct Ctx {
    const float* const* in; float* out; unsigned char* ws; LAS unsigned char* lds;
    int tid, lane, wave, G, bid;
};
#define WSP(T, off) ((T*)(C.ws + (off)))
#define INP(i) (C.in[i])

DI void transpose_item(const float* W, int K, int N, bf16* WT, LAS float* scr, int item, int lane) {
    const int nblk = N / 32, kb = item / nblk, nb = item % nblk, k0 = 64 * kb, n0 = 32 * nb;
#pragma unroll
    for (int i = 0; i < 32; ++i) { const int kk = 2 * i + (lane >> 5); scr[kk * 33 + (lane & 31)] = W[(size_t)(k0 + kk) * N + n0 + (lane & 31)]; }
    asm volatile("s_waitcnt lgkmcnt(0)" ::: "memory");
    const int c = lane & 7;
#pragma unroll
    for (int j = 0; j < 4; ++j) { const int n = (lane >> 3) + 8 * j; const LAS float* s = scr + (8 * c) * 33 + n;
        u32x4 o; o.x = pk2(s[0 * 33], s[1 * 33]); o.y = pk2(s[2 * 33], s[3 * 33]); o.z = pk2(s[4 * 33], s[5 * 33]); o.w = pk2(s[6 * 33], s[7 * 33]);
        *(u32x4*)(WT + (size_t)(n0 + n) * K + k0 + 8 * c) = o; }
    asm volatile("s_waitcnt lgkmcnt(0)" ::: "memory");
}

DI void h2_item(Ctx& C, int l, int Lf, int t0, float* outp) {
    LAS float* emb = (LAS float*)C.lds;
    LAS float* h1s = emb + 64 * 33;
    LAS float* w1s = h1s + 64 * 65;
    LAS float* w2s = w1s + 33 * 64;
    const float* w1 = INP(25) + l * 33 * 64; const float* b1 = INP(26) + l * 64; const float* fq = INP(27) + l * 64;
    const float* w2 = INP(28) + l * 64 * 64; const float* b2 = INP(29) + l * 64;
    const int tid = C.tid;
#pragma unroll
    for (int i = 0; i < 5; ++i) { const int e = tid + NTHR * i; const float v = w1[e < 33 * 64 ? e : 0]; if (e < 33 * 64) w1s[e] = v; }
#pragma unroll
    for (int i = 0; i < 8; ++i) { const int e = tid + NTHR * i; w2s[e] = w2[e]; }
    for (int e = tid; e < 64 * 33; e += NTHR) { const int t2 = e / 33, i = e % 33, t = t0 + t2; float v;
        if (i == 0) v = (float)t / (float)(Lf - 1);
        else { const int bi = (i - 1) & 15; const float band = 1e-4f + (float)bi * ((15.0f - 1e-4f) / 15.0f);
            const float wv = (6.283185307179586f * (float)t) / (float)Lf; const float z = wv * band; v = (i <= 16) ? __cosf(z) : -__sinf(z); }
        emb[e] = v; }
    __syncthreads();
    const int tp = tid & 63, jg = tid >> 6;
    float a[8];
#pragma unroll
    for (int q = 0; q < 8; ++q) a[q] = b1[jg * 8 + q];
#pragma unroll 11
    for (int i = 0; i < 33; ++i) { const float ev = emb[tp * 33 + i];
#pragma unroll
        for (int q = 0; q < 8; ++q) a[q] += ev * w1s[i * 64 + jg * 8 + q]; }
#pragma unroll
    for (int q = 0; q < 8; ++q) h1s[tp * 65 + jg * 8 + q] = __sinf(fq[jg * 8 + q] * a[q]);
    __syncthreads();
#pragma unroll
    for (int q = 0; q < 8; ++q) a[q] = b2[jg * 8 + q];
#pragma unroll 8
    for (int i = 0; i < 64; ++i) { const float hv = h1s[tp * 65 + i];
#pragma unroll
        for (int q = 0; q < 8; ++q) a[q] += hv * w2s[i * 64 + jg * 8 + q]; }
    float o[8];
#pragma unroll
    for (int q = 0; q < 8; ++q) o[q] = __sinf(fq[jg * 8 + q] * a[q]);
    float* dst = outp + (size_t)(t0 + tp) * 64 + jg * 8;
    *(f32x4*)dst = (f32x4){o[0], o[1], o[2], o[3]}; *(f32x4*)(dst + 4) = (f32x4){o[4], o[5], o[6], o[7]};
    __syncthreads();
}

DI void phase0(Ctx& C) {
    const int gw = C.bid * NWV + C.wave, NGW = C.G * NWV;
    {
        LAS float* scr = (LAS float*)(C.lds + C.wave * 16384);
        constexpr int I_IN = 16 * 64, I_OUT = 16 * 32, I_1 = 16 * 128, I_2 = 64 * 32, PER = I_IN + I_OUT + I_1 + I_2;
        for (int it = gw; it < 2 * PER; it += NGW) {
            const int l = it / PER; int r = it % PER;
            if (r < I_IN) { transpose_item(INP(10) + (size_t)l * DM * INC, DM, INC, WSP(bf16, WS_WIN) + (size_t)l * INC * DM, scr, r, C.lane); continue; } r -= I_IN;
            if (r < I_OUT) { transpose_item(INP(11) + (size_t)l * DM * DM, DM, DM, WSP(bf16, WS_WOUT) + (size_t)l * DM * DM, scr, r, C.lane); continue; } r -= I_OUT;
            if (r < I_1) { transpose_item(INP(32) + (size_t)l * DM * DFF, DM, DFF, WSP(bf16, WS_W1) + (size_t)l * DFF * DM, scr, r, C.lane); continue; } r -= I_1;
            transpose_item(INP(33) + (size_t)l * DFF * DM, DFF, DM, WSP(bf16, WS_W2) + (size_t)l * DM * DFF, scr, r, C.lane);
        }
    }
    {
        const int gt = C.bid * NTHR + C.tid, NGT = C.G * NTHR;
        for (int e = gt; e < 2 * 4 * 4096; e += NGT) { const int m = e >> 12, n = (e >> 6) & 63, k = e & 63; WSP(bf16, WS_POOLWT)[e] = (bf16)f2bf(INP(12)[m * 4096 + k * 64 + n]); }
        for (int e = gt; e < 2 * 2 * 2 * 4 * 4096; e += NGT) {
            const int k = e & 63, n = (e >> 6) & 63, blk = (e >> 12) & 3, which = (e >> 14) & 1, d = (e >> 15) & 1, l = e >> 16;
            const float* src = which ? INP(20) : INP(18);
            WSP(bf16, WS_LRUWT)[e] = (bf16)f2bf(src[(((l * 2 + d) * 4 + blk) * 64 + k) * 64 + n]); }
        for (int e = gt; e < 2 * 65536; e += NGT) { const int k = e & 63, col = (e >> 6) & 1023, l = e >> 16; WSP(float, WS_W3T)[e] = INP(30)[(l * 64 + k) * 1024 + col]; }
    }
    __syncthreads();
    {
        LAS float* sc = (LAS float*)C.lds;
        LAS float* red = sc + 3 * 1024;
        for (int e = C.tid; e < 3 * 1024; e += NTHR) { const int i = e >> 10, k = e & 1023; const float v = (i < 2) ? INP(1)[i * 1024 + k] : INP(3)[k]; sc[e] = v / (1.f + __expf(-v)); }
        __syncthreads();
        for (int it = C.bid; it < 192; it += C.G) {
            const int l = it / 96, j = (it % 96) * 64 + C.lane; const float* wm = INP(4) + (size_t)l * DM * 6144 + j;
            float a0 = 0.f, a1 = 0.f, a2 = 0.f; const int kb = C.wave * 128;
#pragma unroll 32
            for (int k = kb; k < kb + 128; ++k) { const float w = wm[(size_t)k * 6144]; a0 += sc[k] * w; a1 += sc[1024 + k] * w; a2 += sc[2048 + k] * w; }
            red[(C.wave * 3 + 0) * 64 + C.lane] = a0; red[(C.wave * 3 + 1) * 64 + C.lane] = a1; red[(C.wave * 3 + 2) * 64 + C.lane] = a2;
            __syncthreads();
            if (C.tid < 192) { const int i = C.tid >> 6, ln = C.tid & 63; float s = 0.f;
                for (int w = 0; w < 8; ++w) s += red[(w * 3 + i) * 64 + ln];
                const int jj = (it % 96) * 64 + ln; WSP(float, WS_MOD)[(l * 3 + i) * 6144 + jj] = s + INP(5)[l * 6144 + jj]; }
            __syncthreads();
        }
    }
    for (int it = C.bid; it < 2 * 256 + 4; it += C.G) {
        if (it < 512) { const int l = it >> 8; h2_item(C, l, SEQ, (it & 255) * 64, WSP(float, WS_H2) + (size_t)l * SEQ * 64); }
        else h2_item(C, 0, CTXL, (it - 512) * 64, WSP(float, WS_H2C));
    }
}

DI int row_cond(int m) { return m < MLAT ? (m >> 14) : 2; }
DI void row_norm_mod(const float* xr, const float* g, const float* shift, const float* scale, bf16* xn, int lane) {
    f32x4 v[4]; float s = 0.f;
#pragma unroll
    for (int j = 0; j < 4; ++j) { v[j] = *(const f32x4*)(xr + 4 * lane + 256 * j); s += (v[j].x * v[j].x + v[j].y * v[j].y) + (v[j].z * v[j].z + v[j].w * v[j].w); }
    const float r = rsqrtf(wave_sum(s) * (1.f / DM) + EPSN);
#pragma unroll
    for (int j = 0; j < 4; ++j) { const int c = 4 * lane + 256 * j; const f32x4 gg = *(const f32x4*)(g + c), sh = *(const f32x4*)(shift + c), sc = *(const f32x4*)(scale + c);
        f32x4 o; o = (v[j] * r * gg) * (sc + 1.0f) + sh;
        u32x2 w; w.x = pk2(o.x, o.y); w.y = pk2(o.z, o.w); *(u32x2*)(xn + c) = w; }
}
template <int NR> DI void row_update(const float* const (&xi)[NR], const bf16* const (&y)[NR], const LAS float* gpost, const LAS float* gate, float* const (&xo)[NR], const LAS float* gnext, const LAS float* shift, const LAS float* scale, bf16* const (&xn)[NR], bool donext, int lane) {
    f32x4 yv[NR][4], xv[NR][4]; float s[NR];
#pragma unroll
    for (int q = 0; q < NR; ++q) { s[q] = 0.f;
#pragma unroll
        for (int j = 0; j < 4; ++j) { const u32x2 w = *(const u32x2*)(y[q] + 4 * lane + 256 * j); yv[q][j] = (f32x4){bflo(w.x), bfhi(w.x), bflo(w.y), bfhi(w.y)}; xv[q][j] = *(const f32x4*)(xi[q] + 4 * lane + 256 * j);
            s[q] += (yv[q][j].x * yv[q][j].x + yv[q][j].y * yv[q][j].y) + (yv[q][j].z * yv[q][j].z + yv[q][j].w * yv[q][j].w); } }
    float s2[NR];
#pragma unroll
    for (int q = 0; q < NR; ++q) { const float r = rsqrtf(wave_sum(s[q]) * (1.f / DM) + EPSN); s2[q] = 0.f;
#pragma unroll
        for (int j = 0; j < 4; ++j) { const int c = 4 * lane + 256 * j; const f32x4 gp = *(const LAS f32x4*)(gpost + c), ga = *(const LAS f32x4*)(gate + c);
            xv[q][j] = xv[q][j] + ga * (yv[q][j] * r * gp); *(f32x4*)(xo[q] + c) = xv[q][j];
            s2[q] += (xv[q][j].x * xv[q][j].x + xv[q][j].y * xv[q][j].y) + (xv[q][j].z * xv[q][j].z + xv[q][j].w * xv[q][j].w); } }
    if (donext) {
#pragma unroll
        for (int q = 0; q < NR; ++q) { const float r2 = rsqrtf(wave_sum(s2[q]) * (1.f / DM) + EPSN);
#pragma unroll
            for (int j = 0; j < 4; ++j) { const int c = 4 * lane + 256 * j; const f32x4 gg = *(const LAS f32x4*)(gnext + c), sh = *(const LAS f32x4*)(shift + c), sc = *(const LAS f32x4*)(scale + c);
                const f32x4 o = (xv[q][j] * r2 * gg) * (sc + 1.0f) + sh; u32x2 w; w.x = pk2(o.x, o.y); w.y = pk2(o.z, o.w); *(u32x2*)(xn[q] + c) = w; } }
    }
}

DI void ft_item(Ctx& C, const float* H2, const float* W3T, float* FT, int Lf, int n0) {
    LAS float* wl = (LAS float*)C.lds;
    const int n = n0 + C.lane; float h[64];
#pragma unroll
    for (int i = 0; i < 16; ++i) { const f32x4 v = *(const f32x4*)(H2 + (size_t)n * 64 + 4 * i); h[4 * i] = v.x; h[4 * i + 1] = v.y; h[4 * i + 2] = v.z; h[4 * i + 3] = v.w; }
    const float t01 = (float)n / (float)(Lf - 1);
    const int wv = __builtin_amdgcn_readfirstlane(C.wave);
#pragma unroll 1
    for (int half = 0; half < 2; ++half) {
        __syncthreads();
#pragma unroll 16
        for (int e = C.tid; e < 512 * 16; e += NTHR) *(LAS f32x4*)(wl + 4 * e) = *(const f32x4*)(W3T + (size_t)half * 32768 + 4 * e);
        __syncthreads();
#pragma unroll 2
        for (int ci = 0; ci < 64; ++ci) {
            const int cl = wv * 64 + ci, col = half * 512 + cl; const LAS float* wc = wl + cl * 64; float a = 0.f;
#pragma unroll
            for (int k4 = 0; k4 < 16; ++k4) { const f32x4 w4 = *(const LAS f32x4*)(wc + 4 * k4); a += h[4 * k4] * w4.x; a += h[4 * k4 + 1] * w4.y; a += h[4 * k4 + 2] * w4.z; a += h[4 * k4 + 3] * w4.w; }
            const int c = col & 255, o = (col >> 8) & 1, dir = col >> 9;
            const float delta = 3.0701134573253944f + (float)c * ((15.350567286626972f - 3.0701134573253944f) / 255.0f);
            FT[(size_t)((o * 2 + dir) * 256 + c) * Lf + n] = a * __expf(-t01 * delta);
        }
    }
    __syncthreads();
}
struct Tile { int b, p0, Ls, m0, lat; };
DI Tile tile_of(int tt) { Tile t; if (tt < 512) { t.lat = 1; t.b = tt >> 8; t.p0 = (tt & 255) * 64; t.Ls = SEQ; t.m0 = t.b * SEQ + t.p0; } else { const int u = tt - 512; t.lat = 0; t.b = u >> 2; t.p0 = (u & 3) * 64; t.Ls = CTXL; t.m0 = MLAT + t.b * CTXL + t.p0; } return t; }

DI void head_norm_rope(const u32x4 (&raw)[4], const float* g, int a, int pos, bool rope, float oscale, bf16* dst) {
    float v[32];
#pragma unroll
    for (int i = 0; i < 4; ++i) unpack8(raw[i], v + 8 * i);
    float ss = 0.f;
#pragma unroll
    for (int i = 0; i < 32; ++i) ss += v[i] * v[i];
    ss += __shfl_xor(ss, 1);
    const float r = rsqrtf(ss * (1.f / 64.f) + EPSN);
#pragma unroll
    for (int i = 0; i < 32; ++i) v[i] = v[i] * r * g[a * 32 + i];
    if (rope) {
        const float coord = (float)(a == 0 ? (pos >> 6) : (pos & 63));
#pragma unroll
        for (int f = 0; f < 16; ++f) { const float inv = exp2f(-(float)f * (13.287712379549449f / 16.0f)); const float ang = coord * inv; const float sn = __sinf(ang), cs = __cosf(ang);
            const float t1 = v[f], t2 = v[16 + f]; v[f] = t1 * cs - t2 * sn; v[16 + f] = t2 * cs + t1 * sn; }
    }
#pragma unroll
    for (int i = 0; i < 4; ++i) { u32x4 w; w.x = pk2(v[8 * i] * oscale, v[8 * i + 1] * oscale); w.y = pk2(v[8 * i + 2] * oscale, v[8 * i + 3] * oscale); w.z = pk2(v[8 * i + 4] * oscale, v[8 * i + 5] * oscale); w.w = pk2(v[8 * i + 6] * oscale, v[8 * i + 7] * oscale);
        *(u32x4*)(dst + 8 * i) = w; }
}

DI void prep_qkv(Ctx& C, int l, const Tile& T) {
    const bf16* PX = WSP(bf16, WS_PX); int tid = C.tid; asm volatile("" : "+v"(tid));
    LAS bf16* vs = (LAS bf16*)C.lds;
    u32x4 qraw[4], xraw[4];
    {
        const int tok = tid >> 3, part = tid & 7, head = part >> 1, a = part & 1;
        const bf16* src = PX + (size_t)(T.m0 + tok) * INC + 256 + head * 64 + a * 32;
#pragma unroll
        for (int i = 0; i < 4; ++i) qraw[i] = *(const u32x4*)(src + 8 * i);
        const int ktok = tid >> 2, kpart = tid & 3, khead = kpart >> 1, ka = kpart & 1, u = tid - 256;
#pragma unroll
        for (int i = 0; i < 4; ++i) { const int e = u + 256 * i, vtok = e >> 4, vch = e & 15;
            const bf16* xs = (tid < 256) ? PX + (size_t)(T.m0 + ktok) * INC + 512 + khead * 64 + ka * 32 + 8 * i : PX + (size_t)(T.m0 + vtok) * INC + 640 + vch * 8;
            xraw[i] = *(const u32x4*)xs; }
    }
    {
        const int tok = tid >> 3, part = tid & 7, head = part >> 1, a = part & 1, pos = T.p0 + tok;
        bf16* dst = T.lat ? WSP(bf16, WS_Q) + ((size_t)(T.b * 4 + head) * SEQ + pos) * 64 + a * 32 : WSP(bf16, WS_QC) + ((size_t)(T.b * 4 + head) * CTXL + pos) * 64 + a * 32;
        head_norm_rope(qraw, INP(14) + l * 64, a, pos, T.lat != 0, 0.125f * 1.4426950408889634f, dst);
    }
    if (tid < 256) {
        const int tok = tid >> 2, part = tid & 3, head = part >> 1, a = part & 1, pos = T.p0 + tok;
        bf16* dst = WSP(bf16, WS_K) + ((size_t)(T.b * 2 + head) * SKV + (T.lat ? CTXL + pos : pos)) * 64 + a * 32;
        head_norm_rope(xraw, INP(15) + l * 64, a, pos, T.lat != 0, 1.0f, dst);
    } else {
        const int u = tid - 256;
#pragma unroll
        for (int i = 0; i < 4; ++i) { const int e = u + 256 * i, tok = e >> 4, ch = e & 15; *(LAS u32x4*)(vs + tok * 136 + ch * 8) = xraw[i]; }
    }
    __syncthreads();
#pragma unroll
    for (int i = 0; i < 2; ++i) { const int task = tid + 512 * i, d = task >> 3, chunk = task & 7; unsigned short e[8];
#pragma unroll
        for (int j = 0; j < 8; ++j) e[j] = vs[(chunk * 8 + j) * 136 + d];
        u32x4 w; w.x = e[0] | ((unsigned)e[1] << 16); w.y = e[2] | ((unsigned)e[3] << 16); w.z = e[4] | ((unsigned)e[5] << 16); w.w = e[6] | ((unsigned)e[7] << 16);
        const int kvh = d >> 6, dd = d & 63;
        *(u32x4*)(WSP(bf16, WS_VT) + ((size_t)(T.b * 2 + kvh) * 64 + dd) * SKV + (T.lat ? CTXL + T.p0 : T.p0) + chunk * 8) = w; }
    __syncthreads();
}

DI void prep_hyena(Ctx& C, int l, const Tile& T, int gsel) {
    const bf16* PX = WSP(bf16, WS_PX); int tid = C.tid; asm volatile("" : "+v"(tid));
    LAS bf16* ts = (LAS bf16*)C.lds;
    {
        u32x4 w[5];
#pragma unroll
        for (int i = 0; i < 5; ++i) { const int e0 = tid + 512 * i, e = e0 < 66 * 32 ? e0 : 66 * 32 - 1; const int r = e >> 5, ch = e & 31, p = T.p0 - 1 + r; const bool ok = (p >= 0 && p < T.Ls); const int pc = ok ? p : T.p0;
            w[i] = *(const u32x4*)(PX + (size_t)(T.m0 - T.p0 + pc) * INC + 1280 + gsel * 256 + ch * 8); if (!ok) w[i] = (u32x4){0u, 0u, 0u, 0u}; }
#pragma unroll
        for (int i = 0; i < 5; ++i) { const int e = tid + 512 * i; if (e < 66 * 32) *(LAS u32x4*)(ts + (e >> 5) * 264 + (e & 31) * 8) = w[i]; }
    }
    __syncthreads();
    const float* cw = INP(23) + l * 3 * 768; const float* cb = INP(24) + l * 768;
    const int col = tid & 255, ci = gsel * 256 + col;
    const float w0 = cw[ci], w1 = cw[768 + ci], w2 = cw[1536 + ci], bb = cb[ci];
#pragma unroll
    for (int i = 0; i < 4; ++i) { const int chunk = (tid >> 8) + 2 * i; float x[10];
#pragma unroll
        for (int j = 0; j < 10; ++j) x[j] = bf2f(ts[(chunk * 8 + j) * 264 + col]);
        float o[8];
#pragma unroll
        for (int j = 0; j < 8; ++j) o[j] = bb + w0 * x[j] + w1 * x[j + 1] + w2 * x[j + 2];
        u32x4 w; w.x = pk2(o[0], o[1]); w.y = pk2(o[2], o[3]); w.z = pk2(o[4], o[5]); w.w = pk2(o[6], o[7]);
        bf16* dst = T.lat ? WSP(bf16, WS_ZT) + ((size_t)(T.b * 768 + ci)) * SEQ + T.p0 + chunk * 8 : WSP(bf16, WS_ZTC) + ((size_t)(T.b * 768 + ci)) * CTXL + T.p0 + chunk * 8;
        *(u32x4*)dst = w; }
    __syncthreads();
}

DI void prep_pool(Ctx& C, int l, const Tile& T) {
    const bf16* PX = WSP(bf16, WS_PX); int tid = C.tid; asm volatile("" : "+v"(tid));
    LAS float* us = (LAS float*)C.lds;
    LAS bf16* dt = (LAS bf16*)(C.lds + 80 * 256 * 4);
    {
        u32x4 w[5];
#pragma unroll
        for (int i = 0; i < 5; ++i) { const int e = tid + 512 * i, r = e >> 5, ch = e & 31, p = T.p0 - 8 + r; const bool ok = (p >= 0 && p < T.Ls); const int pc = ok ? p : T.p0;
            w[i] = *(const u32x4*)(PX + (size_t)(T.m0 - T.p0 + pc) * INC + ch * 8); if (!ok) w[i] = (u32x4){0u, 0u, 0u, 0u}; }
#pragma unroll
        for (int i = 0; i < 5; ++i) { const int e = tid + 512 * i, r = e >> 5, ch = e & 31; float f[8]; unpack8(w[i], f);
#pragma unroll
            for (int j = 0; j < 8; ++j) us[r * 256 + ch * 8 + j] = f[j]; }
    }
    __syncthreads();
    {
        const int col = tid & 255, th = tid >> 8, g = col >> 6, half = 1 << g;
        const int j0 = th * 32; float s = 0.f;
        for (int q = j0 - half; q < j0 + half; ++q) s += us[(q + 8) * 256 + col];
#pragma unroll 4
        for (int j = j0; j < j0 + 32; ++j) {
            const int p = T.p0 + j; int lo = p - half; if (lo < 0) lo = 0; int hi = p + half; if (hi > T.Ls) hi = T.Ls;
            const float d = s * __builtin_amdgcn_rcpf((float)(hi - lo)) - us[(j + 8) * 256 + col];
            dt[j * 264 + col] = (bf16)f2bf(d);
            s += us[(j + half + 8) * 256 + col] - us[(j - half + 8) * 256 + col];
        }
    }
    __syncthreads();
    {
        const int w = C.wave, g = w >> 1, th = w & 1, lane = tid & 63, rr = lane & 15, quad = lane >> 4;
        const bf16* WT = WSP(bf16, WS_POOLWT) + (size_t)(l * 4 + g) * 4096;
        bf16x8 af[2][2];
#pragma unroll
        for (int mt = 0; mt < 2; ++mt)
#pragma unroll
            for (int ks = 0; ks < 2; ++ks) af[mt][ks] = *(const LAS bf16x8*)(dt + (th * 32 + mt * 16 + rr) * 264 + g * 64 + ks * 32 + quad * 8);
        bf16x8 bfr[4][2]; float psc[4];
#pragma unroll
        for (int nt = 0; nt < 4; ++nt) {
#pragma unroll
            for (int ks = 0; ks < 2; ++ks) bfr[nt][ks] = *(const bf16x8*)(WT + (nt * 16 + rr) * 64 + ks * 32 + quad * 8);
            psc[nt] = INP(13)[l * 256 + g * 64 + nt * 16 + rr]; }
#pragma unroll
        for (int nt = 0; nt < 4; ++nt) {
            const int oc = g * 64 + nt * 16 + rr;
#pragma unroll
            for (int mt = 0; mt < 2; ++mt) { f32x4 acc = (f32x4){0.f, 0.f, 0.f, 0.f};
#pragma unroll
                for (int ks = 0; ks < 2; ++ks) acc = __builtin_amdgcn_mfma_f32_16x16x32_bf16(af[mt][ks], bfr[nt][ks], acc, 0, 0, 0);
#pragma unroll
                for (int j = 0; j < 4; ++j) { const int tok = th * 32 + mt * 16 + quad * 4 + j; WSP(bf16, WS_MIX)[(size_t)(T.m0 + tok) * DM + oc] = (bf16)f2bf(acc[j] * psc[nt]); } }
        }
    }
    __syncthreads();
}

template <int PH> DI void lru_item(Ctx& C, int l, const Tile& T, int nb) {
    const bf16* PX = WSP(bf16, WS_PX); int tid = C.tid; asm volatile("" : "+v"(tid)); const int lane = tid & 63;
    LAS float* xcf = (LAS float*)C.lds;
    LAS bf16* xcb = (LAS bf16*)(C.lds + 64 * 65 * 4);
    LAS float* as_ = (LAS float*)(C.lds + 32768);
    LAS float* bs_ = as_ + 2 * 64 * 64;
    {
        const int tok = tid >> 3, c8 = tid & 7, p = T.p0 + tok, ch0 = nb * 64 + c8 * 8; float acc[8];
        const float* cw = INP(16) + l * 4 * 256; const float* cb = INP(17) + l * 256;
#pragma unroll
        for (int j = 0; j < 8; ++j) acc[j] = cb[ch0 + j];
#pragma unroll
        for (int k = 0; k < 4; ++k) { const int q = p + k - 2;
            if (q >= 0 && q < T.Ls) { float f[8]; unpack8(*(const u32x4*)(PX + (size_t)(T.m0 - T.p0 + q) * INC + 768 + ch0), f);
#pragma unroll
                for (int j = 0; j < 8; ++j) acc[j] += cw[k * 256 + ch0 + j] * f[j]; } }
#pragma unroll
        for (int j = 0; j < 8; ++j) xcf[tok * 65 + c8 * 8 + j] = acc[j];
        u32x4 w; w.x = pk2(acc[0], acc[1]); w.y = pk2(acc[2], acc[3]); w.z = pk2(acc[4], acc[5]); w.w = pk2(acc[6], acc[7]);
        *(LAS u32x4*)(xcb + tok * 72 + c8 * 8) = w;
    }
    __syncthreads();
    {
        const int w = C.wave, dir = w >> 2, tq = w & 3, rr = lane & 15, quad = lane >> 4;
        bf16x8 af[2];
#pragma unroll
        for (int ks = 0; ks < 2; ++ks) af[ks] = *(const LAS bf16x8*)(xcb + (tq * 16 + rr) * 72 + ks * 32 + quad * 8);
        const bf16* WA = WSP(bf16, WS_LRUWT) + (size_t)((((l * 2 + dir) * 2 + 0) * 4 + nb)) * 4096;
        const bf16* WX = WSP(bf16, WS_LRUWT) + (size_t)((((l * 2 + dir) * 2 + 1) * 4 + nb)) * 4096;
#pragma unroll
        for (int nt = 0; nt < 4; ++nt) {
            f32x4 ar = (f32x4){0.f, 0.f, 0.f, 0.f}, ai = (f32x4){0.f, 0.f, 0.f, 0.f};
#pragma unroll
            for (int ks = 0; ks < 2; ++ks) { const bf16x8 ba = *(const bf16x8*)(WA + (nt * 16 + rr) * 64 + ks * 32 + quad * 8), bx = *(const bf16x8*)(WX + (nt * 16 + rr) * 64 + ks * 32 + quad * 8);
                ar = __builtin_amdgcn_mfma_f32_16x16x32_bf16(af[ks], ba, ar, 0, 0, 0); ai = __builtin_amdgcn_mfma_f32_16x16x32_bf16(af[ks], bx, ai, 0, 0, 0); }
            const int chl = nt * 16 + rr, ch = nb * 64 + chl; const int pi = (l * 2 + dir) * 256 + ch;
            const float br = INP(19)[pi], bi = INP(21)[pi], lam = INP(22)[pi]; const float sp = log1pf(__expf(-lam));
#pragma unroll
            for (int j = 0; j < 4; ++j) { const int tok = tq * 16 + quad * 4 + j;
                const float r = sigmoidf_(ar[j] + br), ig = sigmoidf_(ai[j] + bi); const float la = -8.0f * r * sp; const float a = __expf(la);
                const float bcoef = __builtin_amdgcn_sqrtf(fmaxf(-expm1f(2.0f * la), 0.f)) * (ig * xcf[tok * 65 + chl]);
                as_[(dir * 64 + tok) * 64 + chl] = a; bs_[(dir * 64 + tok) * 64 + chl] = bcoef; }
        }
    }
    __syncthreads();
    const int cid = T.lat ? 4 + (T.p0 >> 6) : (T.p0 >> 6);
    float* AGG = WSP(float, WS_AGG);
    if (tid < 128) {
        const int dir = tid >> 6, chl = tid & 63, ch = nb * 64 + chl; float h = 0.f;
        if (PH == 2) h = WSP(float, WS_CARRY)[(size_t)(T.b * NCHUNK + cid) * 512 + dir * 256 + ch];
        float A = 1.f;
        if (dir == 0) {
#pragma unroll 16
            for (int t = 0; t < 64; ++t) { const float a = as_[(dir * 64 + t) * 64 + chl], b = bs_[(dir * 64 + t) * 64 + chl]; h = a * h + b; A *= a; if (PH == 2) bs_[(dir * 64 + t) * 64 + chl] = h; } }
        else {
#pragma unroll 16
            for (int t = 63; t >= 0; --t) { const float a = as_[(dir * 64 + t) * 64 + chl], b = bs_[(dir * 64 + t) * 64 + chl]; h = a * h + b; A *= a; if (PH == 2) bs_[(dir * 64 + t) * 64 + chl] = h; } }
        if (PH == 1) { float* ag = AGG + ((size_t)(T.b * NCHUNK + cid) * 2 + dir) * 512 + ch; ag[0] = A; ag[256] = h; }
    }
    __syncthreads();
    if (PH == 2) {
        const int tok = tid >> 3, c8 = tid & 7, ch0 = nb * 64 + c8 * 8; float g[8], o[8];
        unpack8(*(const u32x4*)(PX + (size_t)(T.m0 + tok) * INC + 1024 + ch0), g);
#pragma unroll
        for (int j = 0; j < 8; ++j) o[j] = (bs_[tok * 64 + c8 * 8 + j] + bs_[(64 + tok) * 64 + c8 * 8 + j]) * gelu_tanh(g[j]);
        u32x4 w; w.x = pk2(o[0], o[1]); w.y = pk2(o[2], o[3]); w.z = pk2(o[4], o[5]); w.w = pk2(o[6], o[7]);
        *(u32x4*)(WSP(bf16, WS_MIX) + (size_t)(T.m0 + tok) * DM + 512 + ch0) = w;
        __syncthreads();
    }
}

DI void lru_carry(Ctx& C) {
    if (C.bid >= 16) return;
    const int b = C.bid >> 3, dir = (C.bid >> 2) & 1, ch = (C.bid & 3) * 64 + C.lane, w = C.wave;
    const float* ag = WSP(float, WS_AGG) + (size_t)b * NCHUNK * 1024 + dir * 512 + ch;
    float* cr = WSP(float, WS_CARRY) + (size_t)b * NCHUNK * 512 + dir * 256 + ch;
    LAS float* sa = (LAS float*)C.lds; LAS float* sb = sa + 8 * 64;
    constexpr int SEG = 33;
    const int s0 = w * SEG; float a[SEG], bq[SEG];
#pragma unroll
    for (int i = 0; i < SEG; ++i) { const int s = s0 + i; const int cid = dir == 0 ? s : (s < 4 ? 3 - s : NCHUNK + 3 - s);
        if (s < NCHUNK) { a[i] = ag[(size_t)cid * 1024]; bq[i] = ag[(size_t)cid * 1024 + 256]; } else { a[i] = 1.f; bq[i] = 0.f; } }
    float A = 1.f, B = 0.f;
#pragma unroll
    for (int i = 0; i < SEG; ++i) { B = a[i] * B + bq[i]; A *= a[i]; }
    sa[w * 64 + C.lane] = A; sb[w * 64 + C.lane] = B;
    __syncthreads();
    float h = 0.f;
    for (int w2 = 0; w2 < w; ++w2) h = sa[w2 * 64 + C.lane] * h + sb[w2 * 64 + C.lane];
#pragma unroll
    for (int i = 0; i < SEG; ++i) { const int s = s0 + i; const int cid = dir == 0 ? s : (s < 4 ? 3 - s : NCHUNK + 3 - s);
        if (s < NCHUNK) { cr[(size_t)cid * 512] = h; h = a[i] * h + bq[i]; } }
    __syncthreads();
}
DI float max3f(float a, float b, float c) { float r; asm("v_max3_f32 %0, %1, %2, %3" : "=v"(r) : "v"(a), "v"(b), "v"(c)); return r; }
DI int crow(int r, int hi) { return (r & 3) + 8 * (r >> 2) + 4 * hi; }
DI unsigned cvtpk(float lo, float hi) { typedef __bf16 bf16x2_t __attribute__((ext_vector_type(2))); f32x2v v = {lo, hi}; bf16x2_t b = __builtin_convertvector(v, bf16x2_t); return __builtin_bit_cast(unsigned, b); }
DI void attn_unit(Ctx& C, const bf16* Qp, const bf16* Kp, const bf16* VTp, int NT, bf16* Op, int q0, int nrows) {
    int tid = C.tid; asm volatile("" : "+v"(tid)); const int lane = tid & 63, w = C.wave, r = lane & 31, hi = lane >> 5;
    LAS unsigned char* Ks = C.lds;
    LAS unsigned char* Vs = C.lds + 2 * 9216;
    LAS float* wsf = (LAS float*)(C.lds + 4 * 9216) + w * 64;
    bf16x8 qf[2][4];
#pragma unroll
    for (int g = 0; g < 2; ++g)
#pragma unroll
        for (int d0 = 0; d0 < 4; ++d0) qf[g][d0] = *(const bf16x8*)(Qp + (size_t)(q0 + w * 64 + g * 32 + r) * 64 + d0 * 16 + hi * 8);
    const int srow = tid >> 3, sch = tid & 7;
    u32x4 kreg = *(const u32x4*)(Kp + (size_t)tid * 8);
    u32x4 vreg = *(const u32x4*)(VTp + (size_t)srow * SKV + sch * 8);
    *(LAS u32x4*)(Ks + srow * 144 + sch * 16) = kreg; *(LAS u32x4*)(Vs + srow * 144 + sch * 16) = vreg;
    __syncthreads();
    f32x16 o[2][2];
#pragma unroll
    for (int g = 0; g < 2; ++g)
#pragma unroll
        for (int i = 0; i < 16; ++i) { o[g][0][i] = 0.f; o[g][1][i] = 0.f; }
    float m[2] = {0.f, 0.f}, lsum[2] = {0.f, 0.f};
    bool anym = false;
    for (int t = 0; t < NT; ++t) {
        const int cur = t & 1; const bool more = (t + 1 < NT);
        if (more) { kreg = *(const u32x4*)(Kp + (size_t)(t + 1) * 4096 + (size_t)tid * 8); vreg = *(const u32x4*)(VTp + (size_t)srow * SKV + (t + 1) * 64 + sch * 8); }
        const LAS unsigned char* kb = Ks + cur * 9216 + r * 144 + hi * 16;
        const LAS unsigned char* vb = Vs + cur * 9216 + r * 144 + hi * 8;
        f32x16 p[2][2]; u32x4 pa[2][2][2]; bf16x8 kf[2][4];
        const f32x16 z = {0.f, 0.f, 0.f, 0.f, 0.f, 0.f, 0.f, 0.f, 0.f, 0.f, 0.f, 0.f, 0.f, 0.f, 0.f, 0.f};
#pragma unroll
        for (int d0 = 0; d0 < 4; ++d0) { kf[0][d0] = *(const LAS bf16x8*)(kb + d0 * 32); kf[1][d0] = *(const LAS bf16x8*)(kb + 32 * 144 + d0 * 32); }
#define ATT_QK(g) do { __builtin_amdgcn_s_setprio(1); _Pragma("unroll") for (int d0 = 0; d0 < 4; ++d0) { \
            p[g][0] = __builtin_amdgcn_mfma_f32_32x32x16_bf16(kf[0][d0], qf[g][d0], d0 == 0 ? z : p[g][0], 0, 0, 0); \
            p[g][1] = __builtin_amdgcn_mfma_f32_32x32x16_bf16(kf[1][d0], qf[g][d0], d0 == 0 ? z : p[g][1], 0, 0, 0); } __builtin_amdgcn_s_setprio(0); } while (0)
#define MX3(a, b, c) fmaxf(fmaxf((a), (b)), (c))
#define ATT_MAX(g) do { float mx = MX3(p[g][0][0], p[g][1][0], p[g][0][1]), mx2 = MX3(p[g][1][1], p[g][0][2], p[g][1][2]); \
            _Pragma("unroll") for (int i = 3; i < 15; i += 2) { mx = MX3(mx, p[g][0][i], p[g][1][i]); mx2 = MX3(mx2, p[g][0][i + 1], p[g][1][i + 1]); } \
            mx = MX3(mx, p[g][0][15], p[g][1][15]); mx = fmaxf(mx, mx2); \
            mx = fmaxf(mx, __shfl_xor(mx, 32)); \
            if (__builtin_expect(__any(mx > m[g] + 16.0f), 0)) {      \
                const float dl = fmaxf(mx - m[g], 0.f); m[g] += dl; const float alpha = __builtin_amdgcn_exp2f(-dl); lsum[g] *= alpha; anym = true; \
                if (hi == 0) wsf[g * 32 + r] = alpha; \
                _Pragma("unroll") for (int i = 0; i < 16; ++i) { const float f = wsf[g * 32 + crow(i, hi)]; o[g][0][i] *= f; o[g][1][i] *= f; } } \
            if (__builtin_expect(anym, 0)) { const float mg = m[g];         \
                _Pragma("unroll") for (int i = 0; i < 16; ++i) { p[g][0][i] -= mg; p[g][1][i] -= mg; } } } while (0)
#define ATT_EXP(g) do { float ps = 0.f; \
            _Pragma("unroll") for (int i = 0; i < 16; ++i) { p[g][0][i] = __builtin_amdgcn_exp2f(p[g][0][i]); p[g][1][i] = __builtin_amdgcn_exp2f(p[g][1][i]); ps += p[g][0][i] + p[g][1][i]; } \
            lsum[g] += ps; \
            _Pragma("unroll") for (int kbk = 0; kbk < 2; ++kbk) _Pragma("unroll") for (int s = 0; s < 2; ++s) \
                pa[g][kbk][s] = (u32x4){cvtpk(p[g][kbk][8 * s], p[g][kbk][8 * s + 1]), cvtpk(p[g][kbk][8 * s + 2], p[g][kbk][8 * s + 3]), cvtpk(p[g][kbk][8 * s + 4], p[g][kbk][8 * s + 5]), cvtpk(p[g][kbk][8 * s + 6], p[g][kbk][8 * s + 7])}; } while (0)
#define ATT_PV(g) do { _Pragma("unroll") for (int kbk = 0; kbk < 2; ++kbk) _Pragma("unroll") for (int s = 0; s < 2; ++s) _Pragma("unroll") for (int db = 0; db < 2; ++db) \
            o[g][db] = __builtin_amdgcn_mfma_f32_32x32x16_bf16(__builtin_bit_cast(bf16x8, pa[g][kbk][s]), vf[kbk][s][db], o[g][db], 0, 0, 0); } while (0)
#define ATT_MIX(nv) do { _Pragma("unroll") for (int q_ = 0; q_ < 8; ++q_) { __builtin_amdgcn_sched_group_barrier(0x008, 1, 0); __builtin_amdgcn_sched_group_barrier(0x400, 4, 0); __builtin_amdgcn_sched_group_barrier(0x002, nv, 0); } } while (0)
        ATT_QK(0); ATT_MAX(0);
        asm volatile("" : "+v"(kf[0][0]), "+v"(kf[1][0]));
        ATT_QK(1); ATT_EXP(0); ATT_MIX(6);
        asm volatile("" : "+v"(pa[0][0][0]), "+v"(pa[0][0][1]), "+v"(pa[0][1][0]), "+v"(pa[0][1][1]), "+v"(lsum[0]));
        ATT_MAX(1);
        bf16x8 vf[2][2][2];
#pragma unroll
        for (int kbk = 0; kbk < 2; ++kbk)
#pragma unroll
            for (int s = 0; s < 2; ++s)
#pragma unroll
                for (int db = 0; db < 2; ++db) {
                    const s16x4 lo = *(const LAS s16x4*)(vb + db * 32 * 144 + (kbk * 32 + s * 16) * 2), hh = *(const LAS s16x4*)(vb + db * 32 * 144 + (kbk * 32 + s * 16 + 8) * 2);
                    vf[kbk][s][db] = (bf16x8){lo[0], lo[1], lo[2], lo[3], hh[0], hh[1], hh[2], hh[3]}; }
        ATT_PV(0); ATT_EXP(1); ATT_MIX(6);
        asm volatile("" : "+v"(pa[1][0][0]), "+v"(pa[1][0][1]), "+v"(pa[1][1][0]), "+v"(pa[1][1][1]), "+v"(lsum[1]));
        ATT_PV(1);
#undef ATT_QK
#undef ATT_MAX
#undef MX3
#undef ATT_EXP
#undef ATT_PV
#undef ATT_MIX
        if (more) { *(LAS u32x4*)(Ks + (cur ^ 1) * 9216 + srow * 144 + sch * 16) = kreg; *(LAS u32x4*)(Vs + (cur ^ 1) * 9216 + srow * 144 + sch * 16) = vreg; }
        __syncthreads();
    }
    const bool active = (w * 64 < nrows);
#pragma unroll
    for (int g = 0; g < 2; ++g) {
        float l = lsum[g]; l += __shfl_xor(l, 32);
        if (hi == 0) wsf[g * 32 + r] = 1.f / l;
        if (active) {
#pragma unroll
            for (int i = 0; i < 16; ++i) { const int q = crow(i, hi); const float f = wsf[g * 32 + q]; bf16* orow = Op + (size_t)(q0 + w * 64 + g * 32 + q) * DM;
                orow[r] = (bf16)f2bf(o[g][0][i] * f); orow[32 + r] = (bf16)f2bf(o[g][1][i] * f); }
        }
    }
    __syncthreads();
}

DI f32x2v cmul(f32x2v a, f32x2v b) { return (f32x2v){a.x * b.x - a.y * b.y, a.x * b.y + a.y * b.x}; }
DI int swz(int i) { return i ^ (((i >> 6) & 7) << 2); }
DI f32x2v cmulc(f32x2v a, f32x2v b) { return (f32x2v){a.x * b.x + a.y * b.y, a.y * b.x - a.x * b.y}; }
DI void bfly4f(f32x2v& a0, f32x2v& a1, f32x2v& a2, f32x2v& a3) {
    const f32x2v t0 = a0 + a2, t1 = a0 - a2, t2 = a1 + a3, d = a1 - a3; const f32x2v t3 = (f32x2v){d.y, -d.x};
    a0 = t0 + t2; a1 = t1 + t3; a2 = t0 - t2; a3 = t1 - t3;
}
DI void bfly4i(f32x2v& a0, f32x2v& a1, f32x2v& a2, f32x2v& a3) {
    const f32x2v s0 = a0 + a2, s1 = a0 - a2, s2 = a1 + a3, d = a1 - a3; const f32x2v s3 = (f32x2v){-d.y, d.x};
    a0 = s0 + s2; a1 = s1 + s3; a2 = s0 - s2; a3 = s1 - s3;
}
template <int T, bool INV> DI void fft_pass16(LAS f32x2v* buf, int tid) {
    asm volatile("" : "+v"(tid));
    constexpr float C1 = 0.9238795325112867f, S1 = 0.3826834323650898f, C2 = 0.7071067811865476f;
#pragma unroll 1
    for (int it = 0; it < 2; ++it) {
        const int j = tid + 512 * it, pos = j & (T - 1), base = ((j - pos) << 4) + pos;
        f32x2v e[16];
#pragma unroll
        for (int m = 0; m < 16; ++m) e[m] = buf[swz(base + m * T)];
        const float fr = (float)pos / (float)(16 * T);
        const f32x2v wp = (f32x2v){__builtin_amdgcn_cosf(fr), -__builtin_amdgcn_sinf(fr)};
        const f32x2v wp2 = cmul(wp, wp), wp4 = cmul(wp2, wp2);
        const f32x2v wp8 = cmul(wp4, wp4), wp12 = cmul(wp8, wp4);
        if (!INV) {
#pragma unroll
            for (int m = 0; m < 4; ++m) {
                const f32x2v c16 = (m == 0) ? (f32x2v){1.f, 0.f} : (m == 1) ? (f32x2v){C1, -S1} : (m == 2) ? (f32x2v){C2, -C2} : (f32x2v){S1, -C1};
                const f32x2v w1 = cmul(wp, c16), w2 = cmul(w1, w1), w3 = cmul(w2, w1);
                bfly4f(e[m], e[m + 4], e[m + 8], e[m + 12]);
                e[m + 4] = cmul(e[m + 4], w1); e[m + 8] = cmul(e[m + 8], w2); e[m + 12] = cmul(e[m + 12], w3);
            }
#pragma unroll
            for (int q = 0; q < 4; ++q) {
                bfly4f(e[4 * q], e[4 * q + 1], e[4 * q + 2], e[4 * q + 3]);
                e[4 * q + 1] = cmul(e[4 * q + 1], wp4); e[4 * q + 2] = cmul(e[4 * q + 2], wp8); e[4 * q + 3] = cmul(e[4 * q + 3], wp12);
            }
        } else {
#pragma unroll
            for (int q = 0; q < 4; ++q) {
                e[4 * q + 1] = cmulc(e[4 * q + 1], wp4); e[4 * q + 2] = cmulc(e[4 * q + 2], wp8); e[4 * q + 3] = cmulc(e[4 * q + 3], wp12);
                bfly4i(e[4 * q], e[4 * q + 1], e[4 * q + 2], e[4 * q + 3]);
            }
#pragma unroll
            for (int m = 0; m < 4; ++m) {
                const f32x2v c16 = (m == 0) ? (f32x2v){1.f, 0.f} : (m == 1) ? (f32x2v){C1, -S1} : (m == 2) ? (f32x2v){C2, -C2} : (f32x2v){S1, -C1};
                const f32x2v w1 = cmul(wp, c16), w2 = cmul(w1, w1), w3 = cmul(w2, w1);
                e[m + 4] = cmulc(e[m + 4], w1); e[m + 8] = cmulc(e[m + 8], w2); e[m + 12] = cmulc(e[m + 12], w3);
                bfly4i(e[m], e[m + 4], e[m + 8], e[m + 12]);
            }
        }
#pragma unroll
        for (int m = 0; m < 16; ++m) buf[swz(base + m * T)] = e[m];
    }
    __syncthreads();
}
template <bool INV> DI void fft_pass4_s1(LAS f32x2v* buf, int tid) {
    asm volatile("" : "+v"(tid));
#pragma unroll 2
    for (int it = 0; it < 8; ++it) {
        const int b = swz((tid + 512 * it) << 2);
        f32x2v a0 = buf[b], a1 = buf[b + 1], a2 = buf[b + 2], a3 = buf[b + 3];
        if (!INV) bfly4f(a0, a1, a2, a3); else bfly4i(a0, a1, a2, a3);
        buf[b] = a0; buf[b + 1] = a1; buf[b + 2] = a2; buf[b + 3] = a3;
    }
    __syncthreads();
}
DI void fft_fwd(LAS f32x2v* buf, int tid) { fft_pass16<1024, false>(buf, tid); fft_pass16<64, false>(buf, tid); fft_pass16<4, false>(buf, tid); fft_pass4_s1<false>(buf, tid); }
DI void fft_inv(LAS f32x2v* buf, int tid) { fft_pass4_s1<true>(buf, tid); fft_pass16<4, true>(buf, tid); fft_pass16<64, true>(buf, tid); fft_pass16<1024, true>(buf, tid); }

DI void hyena_unit(Ctx& C, int l, int c, f32x2v* park, int dry = 0) {
    LAS f32x2v* buf = (LAS f32x2v*)C.lds; LAS float* red = (LAS float*)(C.lds + 131072);
    int tid = C.tid; asm volatile("" : "+v"(tid));
    bf16* ZT = WSP(bf16, WS_ZT); const float* FT = WSP(float, WS_FT);
    bf16* u0 = ZT + (size_t)(0 * 768 + 512 + c) * SEQ; bf16* u1 = ZT + (size_t)(1 * 768 + 512 + c) * SEQ;
    f32x2v* spec = park + SEQ;
#pragma unroll 1
    for (int o = 0; o < 2; ++o) {
        const float* hf = FT + (size_t)((o * 2 + 0) * 256 + c) * SEQ; const float* hb = FT + (size_t)((o * 2 + 1) * 256 + c) * SEQ;
        const bf16* g0 = ZT + (size_t)(0 * 768 + o * 256 + c) * SEQ; const bf16* g1 = ZT + (size_t)(1 * 768 + o * 256 + c) * SEQ;
        const float skip = INP(31)[(l * 2 + o) * 256 + c];
        if (o == 0) {
#pragma unroll 32
            for (int n = tid; n < SEQ; n += NTHR) buf[swz(n)] = (f32x2v){bf2f(u0[n]), bf2f(u1[n])};
        }
        __syncthreads(); fft_fwd(buf, tid);
        float sabs = 0.f;
#pragma unroll 32
        for (int n = tid; n < SEQ; n += NTHR) spec[n] = buf[swz(n)];
#pragma unroll 32
        for (int n = tid; n < SEQ; n += NTHR) { const float a = hf[n], b = n ? hb[SEQ - n] : 0.f; sabs += fabsf(a) + fabsf(b); buf[swz(n)] = (f32x2v){a + b, 0.f}; }
        __syncthreads(); fft_fwd(buf, tid);
#pragma unroll 32
        for (int n = tid; n < SEQ; n += NTHR) { const int ns = swz(n); buf[ns] = cmul(buf[ns], spec[n]); }
        __syncthreads(); fft_inv(buf, tid);
#pragma unroll 32
        for (int n = tid; n < SEQ; n += NTHR) park[n] = buf[swz(n)];
#pragma unroll 32
        for (int n = tid; n < SEQ; n += NTHR) { const float fr = (float)n * (1.0f / 32768.0f); const f32x2v wv = (f32x2v){__builtin_amdgcn_cosf(fr), -__builtin_amdgcn_sinf(fr)};
            buf[swz(n)] = cmul((f32x2v){bf2f(u0[n]), bf2f(u1[n])}, wv); }
        __syncthreads(); fft_fwd(buf, tid);
#pragma unroll 32
        for (int n = tid; n < SEQ; n += NTHR) spec[n] = buf[swz(n)];
#pragma unroll 32
        for (int n = tid; n < SEQ; n += NTHR) { const float a = hf[n], b = n ? hb[SEQ - n] : 0.f; const float fr = (float)n * (1.0f / 32768.0f); const float d = a - b;
            buf[swz(n)] = (f32x2v){d * __builtin_amdgcn_cosf(fr), -d * __builtin_amdgcn_sinf(fr)}; }
        __syncthreads(); fft_fwd(buf, tid);
#pragma unroll 32
        for (int n = tid; n < SEQ; n += NTHR) { const int ns = swz(n); buf[ns] = cmul(buf[ns], spec[n]); }
        __syncthreads(); fft_inv(buf, tid);
        sabs = wave_sum(sabs); if (C.lane == 0) red[C.wave] = sabs;
        __syncthreads();
        float tot = 0.f;
#pragma unroll
        for (int w = 0; w < 8; ++w) tot += red[w];
        const float nrm = 1.0f / (32768.0f * tot);
#pragma unroll 1
        for (int n0 = tid; n0 < SEQ; n0 += 8 * NTHR) {
            f32x2v pk[8]; unsigned short r0[8], r1[8], q0[8], q1[8];
#pragma unroll
            for (int k = 0; k < 8; ++k) { const int n = n0 + NTHR * k; pk[k] = park[n]; r0[k] = u0[n]; r1[k] = u1[n]; q0[k] = g0[n]; q1[k] = g1[n]; }
#pragma unroll
            for (int k = 0; k < 8; ++k) { const int n = n0 + NTHR * k; const float fr = (float)n * (1.0f / 32768.0f); const f32x2v wc = (f32x2v){__builtin_amdgcn_cosf(fr), __builtin_amdgcn_sinf(fr)};
                const f32x2v cv = (pk[k] + cmul(buf[swz(n)], wc)) * nrm; const float x0 = bf2f(r0[k]), x1 = bf2f(r1[k]);
                const float y0 = bf2f(q0[k]) * (cv.x + skip * x0), y1 = bf2f(q1[k]) * (cv.y + skip * x1);
                if (dry) { if (y0 == 1.2345e30f) u0[n] = 0; }
                else if (o == 0) { const unsigned b0 = f2bf(y0), b1 = f2bf(y1); u0[n] = (bf16)b0; u1[n] = (bf16)b1; buf[swz(n)] = (f32x2v){bf2f(b0), bf2f(b1)}; }
                else { WSP(bf16, WS_YDT)[(size_t)(0 * 256 + c) * SEQ + n] = (bf16)f2bf(y0); WSP(bf16, WS_YDT)[(size_t)(1 * 256 + c) * SEQ + n] = (bf16)f2bf(y1); } }
        }
        __syncthreads();
    }
}

DI void hyena_ctx_unit(Ctx& C, int l, int c) {
    LAS float* hh = (LAS float*)C.lds; LAS float* us = hh + 512; LAS float* red = us + 512;
    int tid = C.tid; asm volatile("" : "+v"(tid)); const int b = tid >> 8, t = tid & 255; const bf16* ZTC = WSP(bf16, WS_ZTC); const float* FTC = WSP(float, WS_FTC);
    float u = bf2f(ZTC[(size_t)(b * 768 + 512 + c) * CTXL + t]);
    for (int o = 0; o < 2; ++o) {
        float av = 0.f;
        if (tid < 511) { const int i = tid - 255; const float v = (i >= 0) ? FTC[(size_t)((o * 2 + 0) * 256 + c) * CTXL + i] : FTC[(size_t)((o * 2 + 1) * 256 + c) * CTXL - i]; hh[tid] = v; av = fabsf(v); }
        us[b * 256 + t] = u;
        av = wave_sum(av); if ((tid & 63) == 0) red[tid >> 6] = av;
        __syncthreads();
        float tot = 0.f;
#pragma unroll
        for (int w = 0; w < 8; ++w) tot += red[w];
        float acc = 0.f;
#pragma unroll 16
        for (int s2 = 0; s2 < 256; ++s2) acc += hh[255 + t - s2] * us[b * 256 + s2];
        const float gate = bf2f(ZTC[(size_t)(b * 768 + o * 256 + c) * CTXL + t]); const float skip = INP(31)[(l * 2 + o) * 256 + c];
        u = gate * (acc / tot + skip * u);
        __syncthreads();
    }
    WSP(bf16, WS_YDTC)[(size_t)(b * 256 + c) * CTXL + t] = (bf16)f2bf(u);
}

DI void ydt_transpose(Ctx& C, const Tile& T) {
    LAS bf16* ts = (LAS bf16*)C.lds;
    int tid = C.tid; asm volatile("" : "+v"(tid));
#pragma unroll
    for (int i = 0; i < 4; ++i) { const int task = tid + 512 * i, ch = task >> 3, chunk = task & 7;
        const bf16* src = T.lat ? WSP(bf16, WS_YDT) + (size_t)(T.b * 256 + ch) * SEQ + T.p0 + chunk * 8 : WSP(bf16, WS_YDTC) + (size_t)(T.b * 256 + ch) * CTXL + T.p0 + chunk * 8;
        *(LAS u32x4*)(ts + ch * 72 + chunk * 8) = *(const u32x4*)src; }
    __syncthreads();
    const int tok = tid >> 3, cg8 = tid & 7;
#pragma unroll
    for (int q = 0; q < 4; ++q) { unsigned short e[8];
#pragma unroll
        for (int j = 0; j < 8; ++j) e[j] = ts[(cg8 * 32 + q * 8 + j) * 72 + tok];
        u32x4 w; w.x = e[0] | ((unsigned)e[1] << 16); w.y = e[2] | ((unsigned)e[3] << 16); w.z = e[4] | ((unsigned)e[5] << 16); w.w = e[6] | ((unsigned)e[7] << 16);
        *(u32x4*)(WSP(bf16, WS_MIX) + (size_t)(T.m0 + tok) * DM + 768 + cg8 * 32 + q * 8) = w; }
    __syncthreads();
}
#define XB_TMO      128
#define XB_XCNT(j)  (256  + 64 * (j))
#define XB_XSUB(j)  (1280 + 64 * (j))
#define XB_XGEN(j)  (2304 + 64 * (j))
#define XB_TOP      3328
#define XB_TOPGEN   3392
#define XCD_BAR_WORDS 3456
#define XB_SPIN_CAP (1u << 18)

__device__ __forceinline__ unsigned xb_ld(unsigned* p)              { return __hip_atomic_load(p, __ATOMIC_RELAXED, __HIP_MEMORY_SCOPE_AGENT); }
__device__ __forceinline__ unsigned xb_add(unsigned* p, unsigned v) { return __hip_atomic_fetch_add(p, v, __ATOMIC_RELAXED, __HIP_MEMORY_SCOPE_AGENT); }
__device__ __forceinline__ unsigned xb_xcc_id() { return (unsigned)__builtin_amdgcn_s_getreg((3 << 11) | 20) & 0xFu; }
#define XB_SPIN(cond, bar) do { unsigned _sp = 0; while (cond) { __builtin_amdgcn_s_sleep(1); \
    if ((++_sp & 255u) == 0u) { if (xb_ld(&(bar)[XB_TMO])) break; if (_sp > XB_SPIN_CAP) { atomicAdd(&(bar)[XB_TMO], 1u); break; } } } } while (0)

struct XcdBarrier {
    unsigned* bar; unsigned x;
    volatile LAS unsigned* st;
};

__device__ __forceinline__ XcdBarrier xcd_barrier_post(unsigned* bar, volatile LAS unsigned* st) {
    XcdBarrier b; b.bar = bar; b.x = xb_xcc_id(); b.st = st;
    if (threadIdx.x == 0) (void)xb_add(&bar[XB_XCNT(b.x)], 1u);
    return b;
}
__device__ __forceinline__ void xcd_barrier_complete(unsigned* bar, unsigned x, unsigned& nloc, unsigned& nx) {
    const unsigned G = gridDim.x * gridDim.y * gridDim.z;
    unsigned sum, cnt, mine, sp = 0u;
    for (;;) {
        sum = 0u; cnt = 0u; mine = 0u;
#pragma unroll
        for (unsigned j = 0; j < 16; ++j) { const unsigned c = xb_ld(&bar[XB_XCNT(j)]); sum += c; cnt += (c > 0u) ? 1u : 0u; mine = (j == x) ? c : mine; }
        if (sum == G) break;
        __builtin_amdgcn_s_sleep(1);
        if ((++sp & 255u) == 0u) { if (xb_ld(&bar[XB_TMO])) break; if (sp > XB_SPIN_CAP) { atomicAdd(&bar[XB_TMO], 1u); break; } }
    }
    nloc = mine > 0u ? mine : 1u; nx = cnt > 0u ? cnt : 1u;
}

__device__ __forceinline__ void xcd_barrier(const XcdBarrier& b) {
    asm volatile("s_waitcnt vmcnt(0)" ::: "memory");
    __syncthreads();
    if (threadIdx.x == 0) {
        unsigned* bar = b.bar;
        __builtin_amdgcn_s_waitcnt(0);
        unsigned nloc = b.st[0], nx = b.st[1];
        if (nloc == 0u) { xcd_barrier_complete(bar, b.x, nloc, nx); b.st[0] = nloc; b.st[1] = nx; }
        const unsigned old = xb_add(&bar[XB_XSUB(b.x)], 1u);
        const unsigned gen = old / nloc;
        if (old + 1u == (gen + 1u) * nloc) {
            __builtin_amdgcn_fence(__ATOMIC_RELEASE, "agent");
            asm volatile("s_waitcnt vmcnt(0)" ::: "memory");
            const unsigned og = xb_add(&bar[XB_TOP], 1u);
            const unsigned tg = og / nx;
            if (og + 1u == (tg + 1u) * nx) xb_add(&bar[XB_TOPGEN], 1u);
            else XB_SPIN(xb_ld(&bar[XB_TOPGEN]) == tg, bar);
            __builtin_amdgcn_fence(__ATOMIC_ACQUIRE, "agent");
            xb_add(&bar[XB_XGEN(b.x)], 1u);
            asm volatile("s_waitcnt vmcnt(0)" ::: "memory");
        } else {
            XB_SPIN(xb_ld(&bar[XB_XGEN(b.x)]) == gen, bar);
            __builtin_amdgcn_fence(__ATOMIC_ACQUIRE, "agent");
            asm volatile("s_waitcnt vmcnt(0)" ::: "memory");
        }
    }
    __syncthreads();
}
DI void rows_phase(Ctx& C, int l, int which) {
    const int gw = C.bid * NWV + C.wave, NGW = C.G * NWV; const float* MOD = WSP(float, WS_MOD);
#ifndef NO_ROWS
    if (which == 1) {
        for (int m = gw; m < MTOT; m += NGW) { const int cond = row_cond(m); const bool lat = m < MLAT; const float* modl = MOD + (size_t)cond * 6144;
            row_norm_mod(lat ? INP(0) + (size_t)m * DM : INP(2) + (size_t)(m - MLAT) * DM, INP(6), modl, modl + 1024, WSP(bf16, WS_XN) + (size_t)m * DM, C.lane); }
        return;
    }
    constexpr int NR = 4;
    LAS float* PV = (LAS float*)C.lds;
    {
        const bool nxt = (l + 1 < DEPTH); const int ln = (which == 2) ? l : (nxt ? l + 1 : l);
        f32x4 pvr[8];
#pragma unroll
        for (int i = 0; i < 8; ++i) { const int e0 = C.tid + NTHR * i, e = e0 < 3 * 5 * 256 ? e0 : 3 * 5 * 256 - 1; const int cond = e / 1280, v = (e / 256) % 5, c4 = (e & 255) * 4;
            const float* modl = MOD + (size_t)(l * 3 + cond) * 6144; const float* modn = MOD + (size_t)(ln * 3 + cond) * 6144; const float* src;
            if (which == 2) src = (v == 0) ? INP(7) + l * DM : (v == 1) ? modl + 2048 : (v == 2) ? INP(8) + l * DM : (v == 3) ? modl + 3072 : modl + 4096;
            else src = (v == 0) ? INP(9) + l * DM : (v == 1) ? modl + 5120 : (v == 2) ? INP(6) + ln * DM : (v == 3) ? modn : modn + 1024;
            pvr[i] = *(const f32x4*)(src + c4); }
#pragma unroll
        for (int i = 0; i < 8; ++i) { const int e = C.tid + NTHR * i; if (e < 3 * 5 * 256) *(LAS f32x4*)(PV + (e / 256) * 1024 + (e & 255) * 4) = pvr[i]; }
        __syncthreads();
    }
    const int Mr = (l == DEPTH - 1) ? MLAT : MTOT;
    for (int m0 = gw * NR; m0 < Mr; m0 += NGW * NR) {
        const int cond = row_cond(m0); const bool lat = m0 < MLAT; const LAS float* pv = PV + cond * 5 * 1024;
        const float* xi[NR]; const bf16* y[NR]; float* xo[NR]; bf16* xn[NR];
#pragma unroll
        for (int q = 0; q < NR; ++q) { const int m = m0 + q;
            float* xcur = lat ? C.out + (size_t)m * DM : WSP(float, WS_CX) + (size_t)(m - MLAT) * DM;
            const float* xorig = lat ? INP(0) + (size_t)m * DM : INP(2) + (size_t)(m - MLAT) * DM;
            xi[q] = (which == 2 && l == 0) ? xorig : xcur; xo[q] = xcur; xn[q] = WSP(bf16, WS_XN) + (size_t)m * DM;
            y[q] = (which == 2 ? WSP(bf16, WS_PX) : WSP(bf16, WS_MIX)) + (size_t)m * DM; }
        row_update<NR>(xi, y, pv, pv + 1024, xo, pv + 2048, pv + 3072, pv + 4096, xn, which == 2 || (l + 1 < DEPTH), C.lane);
    }
    __syncthreads();
#endif
}
DI void ft_phase(Ctx& C, int l) {
    for (int rep_ = 0; rep_ < (PROBE_FT ? 2 : 1); ++rep_)
    for (int it = C.bid; it < 256 + (l == 0 ? 4 : 0); it += C.G) {
        if (it < 256) ft_item(C, WSP(float, WS_H2) + (size_t)l * SEQ * 64, WSP(float, WS_W3T) + (size_t)l * 65536, WSP(float, WS_FT), SEQ, it * 64);
        else ft_item(C, WSP(float, WS_H2C), WSP(float, WS_W3T), WSP(float, WS_FTC), CTXL, (it - 256) * 64);
    }
}
template <int ACT> DI void gemm_run(Ctx& C, const bf16* A, const bf16* Bt, int M, int N, int K, bf16* O) {
    pg8::Gemm g{A, Bt, M, N, K}; pg8::StaticOrder S; S.init(M, N, C.G, C.bid);
    pg8::EpiBf16<ACT> E{O, N};
#ifndef NO_GEMM
    for (int rep_ = 0; rep_ < (PROBE_GEMM ? 2 : 1); ++rep_)
    pg8::gemm_phase<pg8::EpiBf16<ACT>, pg8::StaticOrder, true, true>((PG8_LAS unsigned char*)C.lds, g, S, E);
#endif
    __syncthreads();
}

#define GSYNC() do { xcd_barrier(bar); if (PROBE_SYNC) xcd_barrier(bar); } while (0)
#define RELAUNDER() do { int t_ = threadIdx.x; asm volatile("" : "+v"(t_)); C.tid = t_; C.lane = t_ & 63; } while (0)
__global__ void __launch_bounds__(NTHR, 2) fwd_megakernel(Args args) {
    extern __shared__ __attribute__((aligned(16))) unsigned char lds_raw[];
    cg::grid_group grid = cg::this_grid();
    Ctx C; C.in = args.in; C.out = args.out; C.ws = args.ws; C.lds = (LAS unsigned char*)lds_raw;
    C.tid = threadIdx.x; C.lane = C.tid & 63; C.wave = __builtin_amdgcn_readfirstlane(C.tid >> 6); C.G = gridDim.x; C.bid = blockIdx.x;
    volatile LAS unsigned* bst = (volatile LAS unsigned*)(C.lds + 131072 + 256);
    if (threadIdx.x < 2) bst[threadIdx.x] = 0u;
    __syncthreads();
    XcdBarrier bar = xcd_barrier_post((unsigned*)args.ws, bst);

#ifndef NO_P0
    phase0(C);
    if (PROBE_P0) { __syncthreads(); RELAUNDER(); phase0(C); }
#endif
    grid.sync(); RELAUNDER();
    rows_phase(C, 0, 1); RELAUNDER();
#ifndef NO_FT
    ft_phase(C, 0);
#endif
    GSYNC(); RELAUNDER();
    for (int l = 0; l < DEPTH; ++l) {
        gemm_run<0>(C, WSP(bf16, WS_XN), WSP(bf16, WS_WIN) + (size_t)l * INC * DM, MTOT, INC, DM, WSP(bf16, WS_PX));
        GSYNC(); RELAUNDER();
#ifndef NO_PREP
        for (int rep_ = 0; rep_ < (PROBE_PREP ? 2 : 1); ++rep_)
        for (int it = C.bid; it < NTILE64 * 9; it += C.G) {
            const int tt = it / 9, sub = it % 9; const Tile T = tile_of(tt);
            if (sub == 0) prep_qkv(C, l, T);
            else if (sub <= 3) prep_hyena(C, l, T, sub - 1);
            else if (sub == 4) prep_pool(C, l, T);
#ifndef NO_LRU
            else lru_item<1>(C, l, T, sub - 5);
#endif
        }
#endif
        GSYNC(); RELAUNDER();
        {
            lru_carry(C);
            const int nat = 256 + (l == 0 ? 8 : 0);
#ifndef NO_ATT
            for (int rep_ = 0; rep_ < (PROBE_ATT ? 2 : 1); ++rep_)
            for (int u = C.bid; u < nat; u += C.G) {
                if (u < 256) { const int b = u >> 7, h = (u >> 5) & 3, qt = u & 31, kvh = h >> 1;
                    attn_unit(C, WSP(bf16, WS_Q) + (size_t)(b * 4 + h) * SEQ * 64, WSP(bf16, WS_K) + (size_t)(b * 2 + kvh) * SKV * 64, WSP(bf16, WS_VT) + (size_t)(b * 2 + kvh) * 64 * SKV, SKV / 64,
                              WSP(bf16, WS_MIX) + (size_t)(b * SEQ) * DM + 256 + h * 64, qt * 512, 512); }
                else { const int uc = u - 256, b = uc >> 2, h = uc & 3, kvh = h >> 1;
                    attn_unit(C, WSP(bf16, WS_QC) + (size_t)(b * 4 + h) * CTXL * 64, WSP(bf16, WS_K) + (size_t)(b * 2 + kvh) * SKV * 64, WSP(bf16, WS_VT) + (size_t)(b * 2 + kvh) * 64 * SKV, CTXL / 64,
                              WSP(bf16, WS_MIX) + (size_t)(MLAT + b * CTXL) * DM + 256 + h * 64, 0, 256); }
            }
#endif
            RELAUNDER();
#ifndef NO_HY
#if PROBE_HY
            for (int c = C.bid; c < 256; c += C.G) hyena_unit(C, l, c, (f32x2v*)(C.ws + WS_XN) + (size_t)C.bid * 2 * SEQ, 1);
            RELAUNDER();
#endif
            for (int c = C.bid; c < 256; c += C.G) hyena_unit(C, l, c, (f32x2v*)(C.ws + WS_XN) + (size_t)C.bid * 2 * SEQ);
#endif
            RELAUNDER();
#ifndef NO_HYC
            if (l == 0) for (int c = C.bid; c < 256; c += C.G) hyena_ctx_unit(C, l, c);
#endif
        }
        GSYNC(); RELAUNDER();
#ifndef NO_TR
        for (int rep_ = 0; rep_ < (PROBE_TR ? 2 : 1); ++rep_)
        for (int tt = C.bid; tt < NTILE64; tt += C.G) ydt_transpose(C, tile_of(tt));
#endif
        RELAUNDER();
#ifndef NO_LRU
        for (int rep_ = 0; rep_ < (PROBE_TR ? 2 : 1); ++rep_)
        for (int it = C.bid; it < NTILE64 * 4; it += C.G) lru_item<2>(C, l, tile_of(it >> 2), it & 3);
#endif
        GSYNC(); RELAUNDER();
        const int Mg = (l == DEPTH - 1) ? MLAT : MTOT;
        gemm_run<0>(C, WSP(bf16, WS_MIX), WSP(bf16, WS_WOUT) + (size_t)l * DM * DM, Mg, DM, DM, WSP(bf16, WS_PX));
        GSYNC(); RELAUNDER();
        rows_phase(C, l, 2);
        if (PROBE_ROWS && l == 0) { RELAUNDER(); rows_phase(C, l, 2); }
        GSYNC(); RELAUNDER();
        gemm_run<2>(C, WSP(bf16, WS_XN), WSP(bf16, WS_W1) + (size_t)l * DFF * DM, Mg, DFF, DM, WSP(bf16, WS_PX));
        GSYNC(); RELAUNDER();
        gemm_run<0>(C, WSP(bf16, WS_PX), WSP(bf16, WS_W2) + (size_t)l * DM * DFF, Mg, DM, DFF, WSP(bf16, WS_MIX));
        GSYNC(); RELAUNDER();
        rows_phase(C, l, 3); RELAUNDER();
        if (l + 1 < DEPTH) {
#ifndef NO_FT
            ft_phase(C, l + 1);
#endif
            GSYNC(); RELAUNDER(); }
    }
}

extern "C" void kernel_launch(void* const* d_in, const int* in_sizes, int n_in, void* d_out, int out_size, void* d_ws, size_t ws_size, hipStream_t stream) {
    static int grid_blocks = 0;
    if (grid_blocks == 0) {
        if (n_in != 34 || ws_size < WS_END) { fprintf(stderr, "kernel_launch: unexpected n_in %d / ws %zu\n", n_in, ws_size); grid_blocks = -1; return; }
        int dev = 0, cus = 0, per_cu = 0;
        hipGetDevice(&dev); hipDeviceGetAttribute(&cus, hipDeviceAttributeMultiprocessorCount, dev);
        if (hipFuncSetAttribute((const void*)fwd_megakernel, hipFuncAttributeMaxDynamicSharedMemorySize, LDS_BYTES) != hipSuccess) { fprintf(stderr, "kernel_launch: hipFuncSetAttribute failed\n"); }
        if (hipOccupancyMaxActiveBlocksPerMultiprocessor(&per_cu, (const void*)fwd_megakernel, NTHR, LDS_BYTES) != hipSuccess || per_cu < 1) per_cu = 1;
        (void)hipGetLastError();
        grid_blocks = cus * per_cu; if (grid_blocks > 256) grid_blocks = 256;
    }
    if (grid_blocks < 0) return;
    Args a{};
    for (int i = 0; i < 34; ++i) a.in[i] = (const float*)d_in[i];
    a.out = (float*)d_out; a.ws = (unsigned char*)d_ws;
    void* kargs[] = {&a};
    if (hipMemsetAsync(d_ws, 0, 65536, stream) != hipSuccess) { fprintf(stderr, "kernel_launch: memset failed\n"); return; }
    hipError_t e = hipLaunchCooperativeKernel((const void*)fwd_megakernel, dim3(grid_blocks), dim3(NTHR), kargs, LDS_BYTES, stream);
    if (e != hipSuccess) fprintf(stderr, "cooperative launch failed: %s (grid %d)\n", hipGetErrorString(e), grid_blocks);
}
```
